# Optimizing an MI355X kernel written in HIP

```python
import jax, jax.numpy as jnp
from jax import lax
import numpy as np

D_MODEL = 2048
BATCH = 4
SEQ = 2048
DEPTH = 1
DEC_BATCH = 8
DEC_SEQ = 4
PAST_LEN = 16384
PAGE_SIZE = 128

N_HEADS = 8
HEAD_DIM = D_MODEL // 16
ATTN_WIDTH = N_HEADS * HEAD_DIM
MOBA_BLOCK = 256
MOBA_TOPK = 3
Q_BLOCK = 16
ROPE_THETA = 500000.0
ROPE_DIM = HEAD_DIM // 4
GMLP_GROUPS = 8
GMLP_CHUNK = 128
GMLP_WIDTH = D_MODEL // 2
GMLP_GROUP_DIM = GMLP_WIDTH // GMLP_GROUPS
IN_WIDTH = 3 * ATTN_WIDTH + 2 * GMLP_WIDTH
FFN_HIDDEN = -(-8 * D_MODEL // (3 * 256)) * 256
PLE_DIM = 256
NORM_EPS = 1e-6
NEG_INF = -1e30

kernel_name = "moba_gmlp_gated_hybrid_step"


def rms_norm(x, g):
    xf = x.astype(jnp.float32)
    y = xf * lax.rsqrt(jnp.mean(xf * xf, axis=-1, keepdims=True) + NORM_EPS)
    return (y * g.astype(jnp.float32)).astype(x.dtype)


def layer_norm(x, g):
    xf = x.astype(jnp.float32)
    xc = xf - jnp.mean(xf, axis=-1, keepdims=True)
    y = xc * lax.rsqrt(jnp.mean(xc * xc, axis=-1, keepdims=True) + NORM_EPS)
    return (y * g.astype(jnp.float32)).astype(x.dtype)


def partial_rope(x, pos):
    half = ROPE_DIM // 2
    freqs = jnp.power(jnp.float32(ROPE_THETA), -2.0 * jnp.arange(half, dtype=jnp.float32) / ROPE_DIM)
    ang = pos.astype(jnp.float32)[:, None] * freqs[None, :]
    cos = jnp.cos(ang)[None, :, None, :]
    sin = jnp.sin(ang)[None, :, None, :]
    xf = x.astype(jnp.float32)
    x1 = xf[..., :half]
    x2 = xf[..., half:ROPE_DIM]
    out = jnp.concatenate([x1 * cos - x2 * sin, x2 * cos + x1 * sin, xf[..., ROPE_DIM:]], axis=-1)
    return out.astype(x.dtype)


def to_blocks(parts):
    B, _, H, hd = parts[0].shape
    L = sum(p.shape[1] for p in parts)
    nb = -(-L // MOBA_BLOCK)
    pad = nb * MOBA_BLOCK - L
    full = jnp.concatenate(list(parts) + [jnp.zeros((B, pad, H, hd), parts[0].dtype)], axis=1)
    return full.reshape(B, nb, MOBA_BLOCK, H, hd)


def moba_block(q, pos, kb, vb, kmean):
    B, Qb, H, hd = q.shape
    NB = kb.shape[1]
    qh = q.transpose(0, 2, 1, 3)
    gate = jnp.einsum('bhqd,bnhd->bhqn', qh.astype(jnp.float32), kmean)
    qblk = pos // MOBA_BLOCK
    past_ok = jnp.arange(NB)[None, :] < qblk[:, None]
    gate = jnp.where(past_ok[None, None], gate, NEG_INF)
    ksel = min(MOBA_TOPK, NB)
    _, sel = lax.top_k(gate, ksel)
    sel_ok = sel < qblk[None, None, :, None]
    own = jnp.broadcast_to(qblk[None, None, :, None], (B, H, Qb, 1)).astype(sel.dtype)
    idx = jnp.concatenate([sel, own], axis=-1)
    slot_ok = jnp.concatenate([sel_ok, jnp.ones((B, H, Qb, 1), bool)], axis=-1)
    bi = jnp.arange(B)[:, None, None, None]
    hi = jnp.arange(H)[None, :, None, None]
    kg = kb[bi, idx, :, hi]
    vg = vb[bi, idx, :, hi]
    kpos = idx[..., None] * MOBA_BLOCK + jnp.arange(MOBA_BLOCK)
    mask = slot_ok[..., None] & (kpos <= pos[None, None, :, None, None])
    s = jnp.einsum('bhqd,bhqskd->bhqsk', qh, kg, preferred_element_type=jnp.float32) * (HEAD_DIM ** -0.5)
    s = jnp.where(mask, s, NEG_INF)
    nslot = idx.shape[-1]
    p = jax.nn.softmax(s.reshape(B, H, Qb, nslot * MOBA_BLOCK), axis=-1).reshape(s.shape)
    o = jnp.einsum('bhqsk,bhqskd->bhqd', p.astype(vg.dtype), vg)
    return o.transpose(0, 2, 1, 3)


def moba_prompt(q, k, v, pos):
    B, S, H, hd = q.shape
    kb = to_blocks([k])
    vb = to_blocks([v])
    kmean = jnp.mean(kb.astype(jnp.float32), axis=2)
    nqb = S // Q_BLOCK
    qs = q.reshape(B, nqb, Q_BLOCK, H, hd).transpose(1, 0, 2, 3, 4)
    ps = pos.reshape(nqb, Q_BLOCK)
    out = lax.map(lambda a: moba_block(a[0], a[1], kb, vb, kmean), (qs, ps))
    return out.transpose(1, 0, 2, 3, 4).reshape(B, S, H, hd)


def moba_sample(q, past_k, k, past_v, v, pos):
    kb = to_blocks([past_k, k])
    vb = to_blocks([past_v, v])
    kmean = jnp.mean(kb.astype(jnp.float32), axis=2)
    return moba_block(q, pos, kb, vb, kmean)


def spatial_gating(u, vn, w_s, b_s):
    B, S, W = vn.shape
    n = min(S, GMLP_CHUNK)
    nc = S // n
    wm = jnp.tril(w_s[:, :n, :n])
    vr = vn.reshape(B, nc, n, GMLP_GROUPS, GMLP_GROUP_DIM)
    s = jnp.einsum('gts,bcsgd->bctgd', wm, vr) + b_s[:, :n].T[None, None, :, :, None]
    return u * s.reshape(B, S, W)


def mixer_inputs(x, pos, g_pre, w_in, g_vn):
    B, S, _ = x.shape
    h = rms_norm(x, g_pre)
    z = h @ w_in
    q, k, v, u, vg = jnp.split(z, [ATTN_WIDTH, 2 * ATTN_WIDTH, 3 * ATTN_WIDTH, 3 * ATTN_WIDTH + GMLP_WIDTH], axis=-1)
    q = partial_rope(q.reshape(B, S, N_HEADS, HEAD_DIM), pos)
    k = partial_rope(k.reshape(B, S, N_HEADS, HEAD_DIM), pos)
    v = v.reshape(B, S, N_HEADS, HEAD_DIM)
    u = jax.nn.gelu(u)
    vn = layer_norm(jax.nn.gelu(vg), g_vn)
    return h, q, k, v, u, vn


def layer_tail(x, h, attn_o, gm_o, p, w_a_out, w_b_out, w_gate, w_o, g_post_mix,
               g_pre_ffn, w_ffn_in, w_ffn_out, g_post_ffn, g_ple, w_ple_gate, w_ple):
    B, S, _ = x.shape
    a = attn_o.reshape(B, S, ATTN_WIDTH) @ w_a_out
    b = gm_o @ w_b_out
    ga, gb = jnp.split(jax.nn.sigmoid(h @ w_gate), 2, axis=-1)
    mix = (ga * a + gb * b) @ w_o
    x = x + rms_norm(mix, g_post_mix)
    a1, g1 = jnp.split(rms_norm(x, g_pre_ffn) @ w_ffn_in, 2, axis=-1)
    f = (jax.nn.silu(a1) * g1) @ w_ffn_out
    x = x + rms_norm(f, g_post_ffn)
    gate = jax.nn.sigmoid(rms_norm(x, g_ple) @ w_ple_gate)
    return x + (p @ w_ple) * gate


def setup_inputs(seed: int = 0) -> dict:
    key = jax.random.key(seed)
    ks = jax.random.split(key, 32)
    f32 = jnp.float32
    n_pages = PAST_LEN // PAGE_SIZE
    n_used = DEC_BATCH * n_pages
    n_pool = n_used + max(1, n_used // 4)

    def nrm(k, shape, scale):
        return jax.random.normal(k, shape, f32) * scale

    def gain(k, shape):
        return 1.0 + 0.05 * jax.random.normal(k, shape, f32)

    page_table = jax.random.permutation(ks[0], n_pool)[:n_used].reshape(DEC_BATCH, n_pages).astype(jnp.int32)
    return {
        "x_prompt": nrm(ks[1], (BATCH, SEQ, D_MODEL), 1.0),
        "x_sample": nrm(ks[2], (DEC_BATCH, DEC_SEQ, D_MODEL), 1.0),
        "cache_k": nrm(ks[3], (DEPTH, n_pool, PAGE_SIZE, N_HEADS, HEAD_DIM), 1.0),
        "cache_v": nrm(ks[4], (DEPTH, n_pool, PAGE_SIZE, N_HEADS, HEAD_DIM), 1.0),
        "page_table": page_table,
        "p_prompt": nrm(ks[5], (DEPTH, BATCH, SEQ, PLE_DIM), 1.0),
        "p_sample": nrm(ks[6], (DEPTH, DEC_BATCH, DEC_SEQ, PLE_DIM), 1.0),
        "g_pre_mix": gain(ks[7], (DEPTH, D_MODEL)),
        "w_in": nrm(ks[8], (DEPTH, D_MODEL, IN_WIDTH), D_MODEL ** -0.5),
        "g_vnorm": gain(ks[9], (DEPTH, GMLP_WIDTH)),
        "w_spatial": nrm(ks[10], (DEPTH, GMLP_GROUPS, GMLP_CHUNK, GMLP_CHUNK), GMLP_CHUNK ** -0.5),
        "b_spatial": 1.0 + 0.1 * jax.random.normal(ks[11], (DEPTH, GMLP_GROUPS, GMLP_CHUNK), f32),
        "w_a_out": nrm(ks[12], (DEPTH, ATTN_WIDTH, D_MODEL), ATTN_WIDTH ** -0.5),
        "w_b_out": nrm(ks[13], (DEPTH, GMLP_WIDTH, D_MODEL), GMLP_WIDTH ** -0.5),
        "w_gate": nrm(ks[14], (DEPTH, D_MODEL, 2 * D_MODEL), D_MODEL ** -0.5),
        "w_o": nrm(ks[15], (DEPTH, D_MODEL, D_MODEL), D_MODEL ** -0.5),
        "g_post_mix": gain(ks[16], (DEPTH, D_MODEL)),
        "g_pre_ffn": gain(ks[17], (DEPTH, D_MODEL)),
        "w_ffn_in": nrm(ks[18], (DEPTH, D_MODEL, 2 * FFN_HIDDEN), D_MODEL ** -0.5),
        "w_ffn_out": nrm(ks[19], (DEPTH, FFN_HIDDEN, D_MODEL), FFN_HIDDEN ** -0.5),
        "g_post_ffn": gain(ks[20], (DEPTH, D_MODEL)),
        "g_ple": gain(ks[21], (DEPTH, D_MODEL)),
        "w_ple_gate": nrm(ks[22], (DEPTH, D_MODEL, D_MODEL), D_MODEL ** -0.5),
        "w_ple": nrm(ks[23], (DEPTH, PLE_DIM, D_MODEL), PLE_DIM ** -0.5),
    }


def reference(x_prompt, x_sample, cache_k, cache_v, page_table, p_prompt, p_sample,
              g_pre_mix, w_in, g_vnorm, w_spatial, b_spatial, w_a_out, w_b_out, w_gate, w_o,
              g_post_mix, g_pre_ffn, w_ffn_in, w_ffn_out, g_post_ffn, g_ple, w_ple_gate, w_ple):
    n_seq = x_prompt.shape[1]
    dec_b, dec_s = x_sample.shape[0], x_sample.shape[1]
    past_len = page_table.shape[1] * cache_k.shape[2]
    pos_p = jnp.arange(n_seq, dtype=jnp.int32)
    pos_s = past_len + jnp.arange(dec_s, dtype=jnp.int32)
    xp, xs = x_prompt, x_sample
    kp_rows, vp_rows, ks_rows, vs_rows, gv_rows = [], [], [], [], []
    for l in range(DEPTH):
        hp, qp, kp, vp, up, vnp = mixer_inputs(xp, pos_p, g_pre_mix[l], w_in[l], g_vnorm[l])
        ap = moba_prompt(qp, kp, vp, pos_p)
        gp = spatial_gating(up, vnp, w_spatial[l], b_spatial[l])
        xp = layer_tail(xp, hp, ap, gp, p_prompt[l], w_a_out[l], w_b_out[l], w_gate[l], w_o[l],
                        g_post_mix[l], g_pre_ffn[l], w_ffn_in[l], w_ffn_out[l], g_post_ffn[l],
                        g_ple[l], w_ple_gate[l], w_ple[l])
        hs, qs, ks_, vs_, us, vns = mixer_inputs(xs, pos_s, g_pre_mix[l], w_in[l], g_vnorm[l])
        past_k = cache_k[l][page_table].reshape(dec_b, past_len, N_HEADS, HEAD_DIM)
        past_v = cache_v[l][page_table].reshape(dec_b, past_len, N_HEADS, HEAD_DIM)
        as_ = moba_sample(qs, past_k, ks_, past_v, vs_, pos_s)
        gs = spatial_gating(us, vns, w_spatial[l], b_spatial[l])
        xs = layer_tail(xs, hs, as_, gs, p_sample[l], w_a_out[l], w_b_out[l], w_gate[l], w_o[l],
                        g_post_mix[l], g_pre_ffn[l], w_ffn_in[l], w_ffn_out[l], g_post_ffn[l],
                        g_ple[l], w_ple_gate[l], w_ple[l])
        kp_rows.append(kp)
        vp_rows.append(vp)
        ks_rows.append(ks_)
        vs_rows.append(vs_)
        gv_rows.append(vns)
    return (xp, xs, jnp.stack(kp_rows), jnp.stack(vp_rows), jnp.stack(ks_rows), jnp.stack(vs_rows), jnp.stack(gv_rows))
```

```cpp
#include <hip/hip_runtime.h>
#include <cstdio>
#include <cstdint>
#include <cmath>
namespace pg8 {
#define PG8_LAS __attribute__((address_space(3)))
typedef unsigned short bf16_t;
typedef short bf16x8 __attribute__((ext_vector_type(8)));
typedef float f32x4 __attribute__((ext_vector_type(4)));
typedef unsigned u32x4 __attribute__((ext_vector_type(4)));
constexpr int BM = 256, BK = 64, HALF = 128, HTB = HALF * BK * 2  , STAGE_BYTES = 8 * HTB, NXCD = 8, WGM = 8;

__host__ __device__ __forceinline__ int lds_byte(int r, int c) { const int st = (r >> 4) * 2 + (c >> 5), rr = r & 15, cc = c & 31, ob = rr * 64 + cc * 2; return st * 1024 + (ob ^ (((ob >> 9) & 1) << 5)); }
__host__ __device__ __forceinline__ void stage_rc(int b, int& R, int& C) { const int st = b / 1024, sb = b % 1024, swz = sb ^ (((sb >> 9) & 1) << 5); R = (st >> 1) * 16 + swz / 64; C = (st & 1) * 32 + (swz % 64) / 2; }
__host__ __device__ __forceinline__ int perm32(int rho) { const int n = rho >> 4, i = rho & 15; return 8 * (i >> 2) + 4 * n + (i & 3); }

struct Unit { int pm, pn; };
struct Gemm { const bf16_t* A; const bf16_t* Bt; int M, N, K; };

struct StaticOrder {
    int nM, nN, nwg, G, c;
    __host__ __device__ void init(int M, int N, int G_, int c_) { nM = M / BM; nN = N / BM; nwg = nM * nN; G = G_; c = c_; }
    __host__ __device__ bool next(int i, Unit& u) const {
        const long L = (long)i * G + c; if (L >= nwg) return false;
        int wgid = (int)L; { const int q = nwg / NXCD, r = nwg % NXCD, xcd = wgid % NXCD, off = wgid / NXCD; wgid = (xcd < r ? xcd * (q + 1) : r * (q + 1) + (xcd - r) * q) + off; }
        const int nig = WGM * nN, gid = wgid / nig, fm = gid * WGM, gsz = (nM - fm) < WGM ? (nM - fm) : WGM;
        u.pm = fm + ((wgid % nig) % gsz); u.pn = (wgid % nig) / gsz; return true;
    }
    __device__ __forceinline__ void a_ready(const Unit&) const {}
    __device__ __forceinline__ void done(const Unit&) const {}
};

__device__ __forceinline__ unsigned cvt_pk_bf16(float lo, float hi) { unsigned r; asm volatile("v_cvt_pk_bf16_f32 %0, %1, %2" : "=v"(r) : "v"(lo), "v"(hi)); return r; }
typedef float f32x2 __attribute__((ext_vector_type(2)));
__device__ __forceinline__ f32x2 gelu_pk(f32x2 v) {
    const f32x2 av = __builtin_elementwise_abs(v), d = av * 0.2316418882f + 1.0f;
    f32x2 t; t.x = __builtin_amdgcn_rcpf(d.x); t.y = __builtin_amdgcn_rcpf(d.y);
    f32x2 q = t * 0.5307027145f + (-0.7265760135f); q = q * t + 0.7107068705f; q = q * t + (-0.142248368f); q = q * t + 0.127414796f; q = q * t;
    const f32x2 s = (v * v) * (-0.72134752044f);
    f32x2 e; e.x = __builtin_amdgcn_exp2f(s.x); e.y = __builtin_amdgcn_exp2f(s.y);
    const f32x2 m = v * (q * e), r = v - m;
    f32x2 o; o.x = v.x < 0.f ? m.x : r.x; o.y = v.y < 0.f ? m.y : r.y; return o;
}
template <class Epi, class Sched, bool ALIGN_EPI = false, bool SP2 = false>
__device__ __forceinline__ void gemm_phase(PG8_LAS unsigned char* lds, const Gemm g, const Sched& S, const Epi& E) {
    const int tid = threadIdx.x, wid = __builtin_amdgcn_readfirstlane(tid >> 6), lane = tid & 63, wr = wid >> 2, wc = wid & 3, fr = lane & 15, fq = lane >> 4;
    const int K = g.K, nt = K / BK;
    unsigned voffA[2], voffB[2];
#pragma unroll
    for (int i = 0; i < 2; ++i) { int R, C; stage_rc(tid * 16 + i * 8192, R, C); const int Rb = Epi::PERM ? ((R & ~31) + perm32(R & 31)) : R;
        voffA[i] = (unsigned)(R * K + C) * 2u; voffB[i] = (unsigned)(Rb * K + C) * 2u; }
    const size_t kstep = (size_t)(BK * 2);
    const size_t hstep = (size_t)HALF * K * 2;
    const size_t tstep = 2 * hstep;
    const unsigned ldsw = (unsigned)wid * 1024u;
    const int aoff = lds_byte(wr * 64 + fr, fq * 8), boff = lds_byte(wc * 32 + fr, fq * 8);
#define PG8_SA(b, h) (((b) * 2 + (h)) * HTB)
#define PG8_SB(b, h) ((4 + (b) * 2 + (h)) * HTB)
#define PG8_STAGE(bufoff, gbase, voff) do { _Pragma("unroll") for (int _i = 0; _i < 2; ++_i) \
        __builtin_amdgcn_global_load_lds((const unsigned*)((const char*)(gbase) + (voff)[_i]), (PG8_LAS unsigned*)(lds + (bufoff) + ldsw + _i * 8192), 16, 0, 0); } while (0)
#define PG8_LDA(dst, b, h) do { _Pragma("unroll") for (int m = 0; m < 4; ++m) _Pragma("unroll") for (int k = 0; k < 2; ++k) dst[m][k] = *(const PG8_LAS bf16x8*)(lds + PG8_SA(b, h) + aoff + m * 2048 + k * 1024); } while (0)
#define PG8_LDB(dst, b, h) do { _Pragma("unroll") for (int n = 0; n < 2; ++n) _Pragma("unroll") for (int k = 0; k < 2; ++k) dst[n][k] = *(const PG8_LAS bf16x8*)(lds + PG8_SB(b, h) + boff + n * 2048 + k * 1024); } while (0)
#define PG8_MMA(ai, bj, At, Bt) do { __builtin_amdgcn_s_setprio(1); _Pragma("unroll") for (int m = 0; m < 4; ++m) _Pragma("unroll") for (int n = 0; n < 2; ++n) _Pragma("unroll") for (int k = 0; k < 2; ++k) \
        acc[ai][bj][m][n] = __builtin_amdgcn_mfma_f32_16x16x32_bf16(Bt[n][k], At[m][k], acc[ai][bj][m][n], 0, 0, 0); __builtin_amdgcn_s_setprio(0); } while (0)
#define PG8_WAIT_V(n) asm volatile("s_waitcnt vmcnt(" #n ")" ::: "memory")
#define PG8_WAIT_L(n) asm volatile("s_waitcnt lgkmcnt(" #n ")" ::: "memory")
#define PG8_BAR __builtin_amdgcn_s_barrier()
#define PG8_SCHED __builtin_amdgcn_sched_barrier(0)
    Unit cur, nxt; int ui = 0;
    if (!S.next(0, cur)) return;
    f32x4 acc[2][2][4][2];
#pragma unroll
    for (int a = 0; a < 2; ++a)
#pragma unroll
        for (int b = 0; b < 2; ++b)
#pragma unroll
            for (int m = 0; m < 4; ++m)
#pragma unroll
                for (int n = 0; n < 2; ++n) acc[a][b][m][n] = (f32x4){0.f, 0.f, 0.f, 0.f};
    bf16x8 At[4][2], B0[2][2], B1[2][2];
    const char* cA = (const char*)g.A + (size_t)cur.pm * tstep; const char* cB = (const char*)g.Bt + (size_t)cur.pn * tstep;
    S.a_ready(cur);
    if constexpr (SP2) {
        PG8_STAGE(PG8_SB(0, 0), cB, voffB); PG8_STAGE(PG8_SB(0, 1), cB + hstep, voffB); PG8_STAGE(PG8_SA(0, 0), cA, voffA); PG8_STAGE(PG8_SA(0, 1), cA + hstep, voffA);
        if (wr == 1) PG8_BAR;
        PG8_WAIT_V(2); PG8_BAR;
        PG8_STAGE(PG8_SB(1, 0), cB + kstep, voffB); PG8_STAGE(PG8_SA(1, 0), cA + kstep, voffA); PG8_STAGE(PG8_SB(1, 1), cB + hstep + kstep, voffB);
        PG8_WAIT_V(6); PG8_BAR;
    } else {
        PG8_STAGE(PG8_SB(0, 0), cB, voffB); PG8_STAGE(PG8_SA(0, 0), cA, voffA); PG8_STAGE(PG8_SB(0, 1), cB + hstep, voffB); PG8_STAGE(PG8_SA(0, 1), cA + hstep, voffA);
        if (wr == 1) PG8_BAR;
        PG8_WAIT_V(4); PG8_BAR;
        PG8_STAGE(PG8_SB(1, 0), cB + kstep, voffB); PG8_STAGE(PG8_SA(1, 0), cA + kstep, voffA); PG8_STAGE(PG8_SB(1, 1), cB + hstep + kstep, voffB);
        PG8_WAIT_V(6); PG8_BAR;
    }
    for (;;) {
        const bool has_next = S.next(ui + 1, nxt);
        const char* nA = has_next ? (const char*)g.A + (size_t)nxt.pm * tstep : cA; const char* nB = has_next ? (const char*)g.Bt + (size_t)nxt.pn * tstep : cB;
        for (int t = 0; t < nt; t += 2) {
            const bool last = (t == nt - 2);
            const char* a1 = cA + (size_t)(t + 1) * kstep;
            const char* a2 = last ? nA : cA + (size_t)(t + 2) * kstep; const char* b2 = last ? nB : cB + (size_t)(t + 2) * kstep;
            const char* a3 = a2 + kstep; const char* b3 = b2 + kstep;
            if (last && has_next) S.a_ready(nxt);
            if constexpr (SP2) {
            PG8_LDB(B0, 0, 0); PG8_LDB(B1, 0, 1); PG8_SCHED; PG8_LDA(At, 0, 0); PG8_STAGE(PG8_SA(1, 1), a1 + hstep, voffA);
            PG8_WAIT_V(8); PG8_WAIT_L(0); PG8_BAR; PG8_MMA(0, 0, At, B0); PG8_MMA(0, 1, At, B1); PG8_BAR; PG8_SCHED;
            PG8_LDA(At, 0, 1); PG8_STAGE(PG8_SB(0, 0), b2, voffB); PG8_STAGE(PG8_SB(0, 1), b2 + hstep, voffB); PG8_STAGE(PG8_SA(0, 0), a2, voffA);
            PG8_WAIT_V(8); PG8_WAIT_L(0); PG8_BAR; PG8_MMA(1, 0, At, B0); PG8_MMA(1, 1, At, B1); PG8_BAR; PG8_SCHED;
            PG8_LDB(B0, 1, 0); PG8_LDB(B1, 1, 1); PG8_SCHED; PG8_LDA(At, 1, 0); PG8_STAGE(PG8_SA(0, 1), a2 + hstep, voffA);
            PG8_WAIT_V(8); PG8_WAIT_L(0); PG8_BAR; PG8_MMA(0, 0, At, B0); PG8_MMA(0, 1, At, B1); PG8_BAR; PG8_SCHED;
            PG8_LDA(At, 1, 1); PG8_STAGE(PG8_SB(1, 0), b3, voffB); PG8_STAGE(PG8_SB(1, 1), b3 + hstep, voffB); PG8_STAGE(PG8_SA(1, 0), a3, voffA);
            PG8_WAIT_V(8); PG8_WAIT_L(0); PG8_BAR; PG8_MMA(1, 0, At, B0); PG8_MMA(1, 1, At, B1); PG8_BAR; PG8_SCHED;
            } else {
            PG8_LDB(B0, 0, 0); PG8_SCHED; PG8_LDA(At, 0, 0); PG8_STAGE(PG8_SA(1, 1), a1 + hstep, voffA);
            PG8_WAIT_L(8); PG8_BAR; PG8_WAIT_L(0); PG8_MMA(0, 0, At, B0); PG8_BAR; PG8_SCHED;
            PG8_LDB(B1, 0, 1); PG8_STAGE(PG8_SB(0, 0), b2, voffB);
            PG8_BAR; PG8_WAIT_L(0); PG8_MMA(0, 1, At, B1); PG8_BAR;
            PG8_LDA(At, 0, 1); PG8_STAGE(PG8_SA(0, 0), a2, voffA);
            PG8_BAR; PG8_WAIT_L(0); PG8_MMA(1, 0, At, B0); PG8_BAR; PG8_SCHED;
            PG8_STAGE(PG8_SB(0, 1), b2 + hstep, voffB);
            PG8_WAIT_V(6); PG8_BAR; PG8_MMA(1, 1, At, B1); PG8_BAR;
            PG8_LDB(B0, 1, 0); PG8_SCHED; PG8_LDA(At, 1, 0); PG8_STAGE(PG8_SA(0, 1), a2 + hstep, voffA);
            PG8_WAIT_L(8); PG8_BAR; PG8_WAIT_L(0); PG8_MMA(0, 0, At, B0); PG8_BAR; PG8_SCHED;
            PG8_LDB(B1, 1, 1); PG8_STAGE(PG8_SB(1, 0), b3, voffB);
            PG8_BAR; PG8_WAIT_L(0); PG8_MMA(0, 1, At, B1); PG8_BAR;
            PG8_LDA(At, 1, 1); PG8_STAGE(PG8_SA(1, 0), a3, voffA);
            PG8_BAR; PG8_WAIT_L(0); PG8_MMA(1, 0, At, B0); PG8_BAR; PG8_SCHED;
            PG8_STAGE(PG8_SB(1, 1), b3 + hstep, voffB);
            PG8_WAIT_V(6); PG8_BAR; PG8_MMA(1, 1, At, B1); PG8_BAR;
            }
        }
        if constexpr (ALIGN_EPI) { if (wr == 0) PG8_BAR; }
        if constexpr (!Epi::AFTER_DRAIN) { E(acc, cur, wr, wc, fr, fq); S.done(cur); }
        if (!has_next) break;
#pragma unroll
        for (int a = 0; a < 2; ++a)
#pragma unroll
            for (int b = 0; b < 2; ++b)
#pragma unroll
                for (int m = 0; m < 4; ++m)
#pragma unroll
                    for (int n = 0; n < 2; ++n) acc[a][b][m][n] = (f32x4){0.f, 0.f, 0.f, 0.f};
        cur = nxt; cA = nA; cB = nB; ++ui;
        if constexpr (ALIGN_EPI) { if (wr == 1) PG8_BAR; }
    }
    PG8_WAIT_V(0);
    if constexpr (!ALIGN_EPI) { if (wr == 0) PG8_BAR; }
    PG8_BAR;
    if constexpr (Epi::AFTER_DRAIN) { E.fused(acc, cur, wr, wc, fr, fq, lds, wid, lane); S.done(cur); }
#undef PG8_SA
#undef PG8_SB
#undef PG8_STAGE
#undef PG8_LDA
#undef PG8_LDB
#undef PG8_MMA
#undef PG8_WAIT_V
#undef PG8_WAIT_L
#undef PG8_BAR
#undef PG8_SCHED
}
}
namespace att {
typedef unsigned short bf16;
typedef short bf16x8 __attribute__((ext_vector_type(8)));
typedef short s16x4 __attribute__((ext_vector_type(4)));
typedef float f32x16 __attribute__((ext_vector_type(16)));
typedef float f32x4 __attribute__((ext_vector_type(4)));
typedef unsigned u32x4 __attribute__((ext_vector_type(4)));
constexpr int D = 128, PITCH = 1024, SKV = 2048;
constexpr float SCALE = 0.08838834764831845f;
constexpr float THR = 8.f;
constexpr int NW = 8, QBLK = 32, KVBLK = 64, QB = NW * QBLK;
constexpr int SHM_V = KVBLK * D * 2, SHM_K = KVBLK * D * 2;
constexpr int LDS_BYTES = 2 * SHM_V + 2 * SHM_K + NW * 64 * 4;

#define KSWZ(row, colB) ((row) * 256 + ((colB) ^ (((row) & 7) << 4)))
#define SBAR() __builtin_amdgcn_sched_barrier(0)
__device__ __forceinline__ int v_st(int k, int c) { const int kk = (k & ~0xC) | ((k & 4) << 1) | ((k & 8) >> 1); return ((kk >> 3) * 4 + (c >> 5)) * 512 + ((kk & 7) * 32 + (c & 31)) * 2; }
__device__ __forceinline__ int v_rd_base(int lane) { return ((lane & 3) << 3) | (((lane >> 2) & 3) << 6) | (((lane >> 4) & 1) << 5) | (((lane >> 5) & 1) << 8); }
constexpr int v_rd_off(int d0, int ks, int half) { return d0 * 512 + ks * 4096 + half * 2048; }
__device__ __forceinline__ int crow(int r, int hi) { return (r & 3) + 8 * (r >> 2) + 4 * hi; }
__device__ __forceinline__ unsigned cvtpk(float lo, float hi) {
    unsigned r; asm volatile("v_cvt_pk_bf16_f32 %0, %1, %2" : "=v"(r) : "v"(lo), "v"(hi)); return r;
}
__device__ __forceinline__ bf16x8 load8(const bf16* p) { return *reinterpret_cast<const bf16x8*>(p); }
__device__ __forceinline__ void mask_tile(f32x16& p0, f32x16& p1, int dq, unsigned W) {
    const float NEG = -__builtin_inff();
#pragma unroll
    for (int r = 0; r < 16; ++r) {
        const int c = (r & 3) + 8 * (r >> 2);
        if ((unsigned)(dq - c) >= W) p0[r] = NEG;
        if ((unsigned)(dq - c - 32) >= W) p1[r] = NEG;
    }
}
__device__ __forceinline__ void partialSM(f32x16& p0, f32x16& p1, float& m_reg, float& mn, float& alpha) {
    float pmax = p0[0]; for (int r = 1; r < 16; ++r) pmax = fmaxf(pmax, p0[r]); for (int r = 0; r < 16; ++r) pmax = fmaxf(pmax, p1[r]);
    { auto rr = __builtin_amdgcn_permlane32_swap(__float_as_uint(pmax), __float_as_uint(pmax), false, false);
      pmax = fmaxf(__uint_as_float(rr[0]), __uint_as_float(rr[1])); }
    constexpr float C2 = 1.4426950408889634f * SCALE;
    if (__builtin_expect(__all((pmax - m_reg) * SCALE <= THR), 1)) { mn = m_reg; alpha = 1.f; }
    else { mn = fmaxf(m_reg, pmax); alpha = __builtin_amdgcn_exp2f((m_reg - mn) * C2); m_reg = mn; }
    const float mnL = -mn * C2;
    for (int r = 0; r < 16; ++r) p0[r] = fmaf(p0[r], C2, mnL); for (int r = 0; r < 16; ++r) p1[r] = fmaf(p1[r], C2, mnL);
    for (int r = 0; r < 16; ++r) p0[r] = __builtin_amdgcn_exp2f(p0[r]);
}
__device__ __forceinline__ void finishSM(f32x16& p0, f32x16& p1, float alpha, float& l_reg, bf16x8& pa0, bf16x8& pa1, bf16x8& pa2, bf16x8& pa3) {
    for (int r = 0; r < 16; ++r) p1[r] = __builtin_amdgcn_exp2f(p1[r]);
    float ps = 0; for (int r = 0; r < 16; ++r) ps += p0[r]; for (int r = 0; r < 16; ++r) ps += p1[r];
    { auto rr = __builtin_amdgcn_permlane32_swap(__float_as_uint(ps), __float_as_uint(ps), false, false);
      ps = __uint_as_float(rr[0]) + __uint_as_float(rr[1]); }
    l_reg = l_reg * alpha + ps;
#define PK4(P, B_, OUT) do { unsigned a0 = cvtpk(P[B_+0], P[B_+1]), a1 = cvtpk(P[B_+2], P[B_+3]);                          \
        unsigned b0 = cvtpk(P[B_+4], P[B_+5]), b1 = cvtpk(P[B_+6], P[B_+7]);                                             \
        auto r0 = __builtin_amdgcn_permlane32_swap(a0, b0, false, false); auto r1 = __builtin_amdgcn_permlane32_swap(a1, b1, false, false); \
        u32x4 w = {r0[0], r1[0], r0[1], r1[1]}; OUT = *reinterpret_cast<bf16x8*>(&w); } while (0)
    PK4(p0, 0, pa0); PK4(p0, 8, pa1); PK4(p1, 0, pa2); PK4(p1, 8, pa3);
#undef PK4
}
template <int KB>
__device__ __forceinline__ void qkt(f32x16& p0, f32x16& p1, const char* K_lds, int r32, int hi, const bf16x8* qr) {
    p0 = f32x16{}; p1 = f32x16{};
    const char* kb[4];
#pragma unroll
    for (int dd = 0; dd < 4; ++dd) kb[dd] = K_lds + KB * SHM_K + KSWZ(r32, (dd * 16 + hi * 8) * 2);
#pragma unroll
    for (int d0 = 0; d0 < 8; ++d0) { const char* a = kb[d0 & 3] + (d0 >> 2) * 128;
        bf16x8 b0 = *reinterpret_cast<const bf16x8*>(a);
        bf16x8 b1 = *reinterpret_cast<const bf16x8*>(a + 32 * 256);
        p0 = __builtin_amdgcn_mfma_f32_32x32x16_bf16(b0, qr[d0], p0, 0, 0, 0);
        p1 = __builtin_amdgcn_mfma_f32_32x32x16_bf16(b1, qr[d0], p1, 0, 0, 0); }
}
template <int VB>
__device__ __forceinline__ void pv_tile(f32x16* o, int vb0, bf16x8 pa0, bf16x8 pa1, bf16x8 pa2, bf16x8 pa3) {
#define TRRD(dst, off) asm volatile("ds_read_b64_tr_b16 %0, %1 offset:%2" : "=&v"(dst) : "v"(vb0), "i"(off) : "memory")
#define PV_D0(d0) do { s16x4 l0, l1, l2, l3, h0, h1, h2, h3; constexpr int b_ = VB * SHM_V + v_rd_off(d0, 0, 0); \
        TRRD(l0, b_); TRRD(h0, b_ + 2048); TRRD(l1, b_ + 4096); TRRD(h1, b_ + 6144); TRRD(l2, b_ + 8192); TRRD(h2, b_ + 10240); TRRD(l3, b_ + 12288); TRRD(h3, b_ + 14336); \
        asm volatile("s_waitcnt lgkmcnt(0)" ::: "memory"); SBAR();   \
        o[d0] = __builtin_amdgcn_mfma_f32_32x32x16_bf16(pa0, (bf16x8){l0[0], l0[1], l0[2], l0[3], h0[0], h0[1], h0[2], h0[3]}, o[d0], 0, 0, 0);   \
        o[d0] = __builtin_amdgcn_mfma_f32_32x32x16_bf16(pa1, (bf16x8){l1[0], l1[1], l1[2], l1[3], h1[0], h1[1], h1[2], h1[3]}, o[d0], 0, 0, 0);   \
        o[d0] = __builtin_amdgcn_mfma_f32_32x32x16_bf16(pa2, (bf16x8){l2[0], l2[1], l2[2], l2[3], h2[0], h2[1], h2[2], h2[3]}, o[d0], 0, 0, 0);   \
        o[d0] = __builtin_amdgcn_mfma_f32_32x32x16_bf16(pa3, (bf16x8){l3[0], l3[1], l3[2], l3[3], h3[0], h3[1], h3[2], h3[3]}, o[d0], 0, 0, 0); } while (0)
    PV_D0(0); PV_D0(1); PV_D0(2); PV_D0(3);
#undef PV_D0
#undef TRRD
}

struct BlockRef { const bf16* Q; const bf16* K; const bf16* V; bf16* O; const float* km; int P0; };
struct Seam { bf16x8 qr[8]; bf16x8 st_v0, st_v1, st_k0, st_k1; };
constexpr int KM_STRIDE = 2048, KM_HALF = 1024;
#define VMW() asm volatile("s_waitcnt vmcnt(0)" ::: "memory")
#define VMWN(n) asm volatile("s_waitcnt vmcnt(%0)" :: "i"(n) : "memory")
#define SLOAD_H(Kp, Vp, k0) do { const bf16* ku_ = (Kp) + (size_t)(k0) * PITCH; const bf16* vu_ = (Vp) + (size_t)(k0) * PITCH;     \
                         unsigned lo_ = loff; asm volatile("" : "+v"(lo_));                                   \
                         S.st_v0 = load8(vu_ + lo_); S.st_v1 = load8(vu_ + 32 * PITCH + lo_);              \
                         S.st_k0 = load8(ku_ + lo_); S.st_k1 = load8(ku_ + 32 * PITCH + lo_); } while (0)
#define SWRITE_HK(bf) do { *(bf16x8*)(K_lds + (bf) * SHM_K + kws) = S.st_k0; *(bf16x8*)(K_lds + (bf) * SHM_K + kws + 32 * 256) = S.st_k1; } while (0)
#define SWRITE_HV(bf) do { *(bf16x8*)(V_lds + (bf) * SHM_V + vst0) = S.st_v0; *(bf16x8*)(V_lds + (bf) * SHM_V + vst1) = S.st_v1; } while (0)
#define SWRITE_H(bf) do { SWRITE_HV(bf); SWRITE_HK(bf); } while (0)
__device__ __forceinline__ void moba_gate(const BlockRef& cur, char* lds) {
    const int tid = threadIdx.x, wid = __builtin_amdgcn_readfirstlane(tid >> 6), lane = tid & 63, r32 = lane & 31, hi = lane >> 5;
    const int qb = cur.P0 >> 8;
    bf16x8 qr[8];
#pragma unroll
    for (int d0 = 0; d0 < 8; ++d0) qr[d0] = load8(cur.Q + (size_t)(wid * QBLK) * PITCH + (unsigned)(r32 * PITCH + hi * 8) + d0 * 16);
    float v1 = -3.0e38f, v2 = -3.0e38f, v3 = -3.0e38f; int i1 = 31, i2 = 31, i3 = 31;
#pragma unroll 1
    for (int j = 0; j < qb; ++j) {
        const float* kmj = cur.km + (size_t)j * KM_STRIDE; const unsigned ko = (unsigned)(hi * 8);
        float acc = 0.f;
#pragma unroll
        for (int d0 = 0; d0 < 8; ++d0) {
            const f32x4 a0 = *(const f32x4*)(kmj + ko + d0 * 16), a1 = *(const f32x4*)(kmj + ko + d0 * 16 + 4);
            const f32x4 b0 = *(const f32x4*)(kmj + KM_HALF + ko + d0 * 16), b1 = *(const f32x4*)(kmj + KM_HALF + ko + d0 * 16 + 4);
            const f32x4 k0 = a0 + b0, k1 = a1 + b1;
            const bf16x8 q = qr[d0];
            acc += __uint_as_float((unsigned)(unsigned short)q[0] << 16) * k0[0] + __uint_as_float((unsigned)(unsigned short)q[1] << 16) * k0[1]
                 + __uint_as_float((unsigned)(unsigned short)q[2] << 16) * k0[2] + __uint_as_float((unsigned)(unsigned short)q[3] << 16) * k0[3]
                 + __uint_as_float((unsigned)(unsigned short)q[4] << 16) * k1[0] + __uint_as_float((unsigned)(unsigned short)q[5] << 16) * k1[1]
                 + __uint_as_float((unsigned)(unsigned short)q[6] << 16) * k1[2] + __uint_as_float((unsigned)(unsigned short)q[7] << 16) * k1[3];
        }
        const float g = acc + __shfl_xor(acc, 32);
        if (g > v1) { v3 = v2; i3 = i2; v2 = v1; i2 = i1; v1 = g; i1 = j; }
        else if (g > v2) { v3 = v2; i3 = i2; v2 = g; i2 = j; }
        else if (g > v3) { v3 = g; i3 = j; }
    }
    if (hi == 0) ((unsigned*)(lds + LDS_BYTES))[qb * 256 + wid * QBLK + r32] = ((1u << i1) | (1u << i2) | (1u << i3)) & 0x7fu;
}
__device__ __forceinline__ void moba_prime(const BlockRef& cur, char* lds, Seam& S) {
    const int tid = threadIdx.x, wid = __builtin_amdgcn_readfirstlane(tid >> 6), lane = tid & 63, r32 = lane & 31, hi = lane >> 5;
    const int sr = tid >> 4, sc = (tid & 15) * 8, kws = KSWZ(sr, sc * 2); char* K_lds = lds + 2 * SHM_V;
    const unsigned loff = (unsigned)(sr * PITCH + sc), qoff = (unsigned)(r32 * PITCH + hi * 8);
    { const bf16* qu = cur.Q + (size_t)(wid * QBLK) * PITCH;
    for (int d0 = 0; d0 < 8; ++d0) S.qr[d0] = load8(qu + qoff + d0 * 16); }
    SLOAD_H(cur.K, cur.V, 0); VMW(); SWRITE_HK(0);
    __syncthreads();
}
__device__ __forceinline__ void moba_block(const BlockRef& cur, const BlockRef& nxt, char* lds, Seam& S) {
    const int tid = threadIdx.x, wid = __builtin_amdgcn_readfirstlane(tid >> 6), lane = tid & 63, r32 = lane & 31, hi = lane >> 5;
    constexpr unsigned W = 0x40000000u;
    const int qb = cur.P0 >> 8;
    const int NT = (cur.P0 + QB) / KVBLK;
    const int qlo = cur.P0 + wid * QBLK, qm = qlo + r32 - 4 * hi;
    char* V_lds = lds; char* K_lds = lds + 2 * SHM_V;
    float* ws = (float*)(lds + 2 * SHM_V + 2 * SHM_K) + wid * 64; float* li_l = ws, * al_l = ws + 32;
    float m_reg = -1e30f, l_reg = 0; f32x16 o[4] = {};
    const int sr = tid >> 4, sc = (tid & 15) * 8, vst0 = v_st(sr, sc), vst1 = v_st(32 + sr, sc), kws = KSWZ(sr, sc * 2);
    const unsigned loff = (unsigned)(sr * PITCH + sc), qoff = (unsigned)(r32 * PITCH + hi * 8);
    const int vb0 = (int)(uintptr_t)V_lds + v_rd_base(lane);
    const bf16* Kh = cur.K; const bf16* Vh = cur.V;
    const unsigned* selp = (const unsigned*)(lds + LDS_BYTES) + (cur.P0 >> 8) * 256 + wid * QBLK + r32;
#define RESC(a) do { if (__any((a) < 1.f)) { if (hi == 0) al_l[r32] = (a); asm volatile("s_waitcnt lgkmcnt(0)" ::: "memory");              \
                     for (int d_ = 0; d_ < 4; ++d_) for (int r = 0; r < 16; ++r) o[d_][r] *= al_l[crow(r, hi)]; } } while (0)
#define KBASE(t) ((t) * KVBLK)
#define MASKT(P0_, P1_, t) do { const int kb_ = KBASE(t); if (kb_ + KVBLK - 1 > qlo) mask_tile(P0_, P1_, qm - kb_, W); \
        const int blk_ = kb_ >> 8; if (blk_ < qb) { const bool keep_ = (*selp >> blk_) & 1u; const float NEG_ = -__builtin_inff(); \
            _Pragma("unroll") for (int r_ = 0; r_ < 16; ++r_) { P0_[r_] = keep_ ? P0_[r_] : NEG_; P1_[r_] = keep_ ? P1_[r_] : NEG_; } } } while (0)
    constexpr int NQL = 8;
#define SEAM_K0() do { VMWN(NQL); SWRITE_HK(0); SBAR(); } while (0)
    f32x16 pA0, pA1, pB0, pB1; float mnA, mnB, alA, alB; bf16x8 pa0, pa1, pa2, pa3;
    SWRITE_HV(0); SBAR();
    if (NT > 1) { SLOAD_H(Kh, Vh, KBASE(1)); }
    SBAR(); qkt<0>(pA0, pA1, K_lds, r32, hi, S.qr);
    MASKT(pA0, pA1, 0); partialSM(pA0, pA1, m_reg, mnA, alA);
    if (NT > 1) { VMW(); SWRITE_H(1); }
    __syncthreads();
#define HALF_STEP(PX0, PX1, mnX, alX, PY0, PY1, alY, t, KB, VB, SB) do {                                                      \
        SBAR(); qkt<KB>(PX0, PX1, K_lds, r32, hi, S.qr);                                             \
        finishSM(PY0, PY1, alY, l_reg, pa0, pa1, pa2, pa3); SBAR();                                                           \
        if ((t) + 1 < NT) { SLOAD_H(Kh, Vh, KBASE((t) + 1)); SBAR(); }                                               \
        pv_tile<VB>(o, vb0, pa0, pa1, pa2, pa3); MASKT(PX0, PX1, (t)); partialSM(PX0, PX1, m_reg, mnX, alX);                                        \
        __syncthreads();                                                                                                      \
        if ((t) + 1 < NT) { VMW(); SWRITE_H(SB); }                                                                          \
        RESC(alX); __syncthreads(); } while (0)
    for (int t = 1; t + 1 < NT; t += 2) {
        HALF_STEP(pB0, pB1, mnB, alB, pA0, pA1, alA, t, 1, 0, 0);
        HALF_STEP(pA0, pA1, mnA, alA, pB0, pB1, alB, t + 1, 0, 1, 1);
    }
    const bool even = (NT & 1) == 0;
    if (even) { SBAR(); qkt<1>(pB0, pB1, K_lds, r32, hi, S.qr); SBAR(); }
    { SLOAD_H(nxt.K, nxt.V, 0); SBAR();
#pragma unroll
        for (int d0 = 0; d0 < 8; ++d0) S.qr[d0] = load8(nxt.Q + (size_t)(wid * QBLK) * PITCH + qoff + d0 * 16); }
    SBAR();
    finishSM(pA0, pA1, alA, l_reg, pa0, pa1, pa2, pa3); SBAR();
    pv_tile<0>(o, vb0, pa0, pa1, pa2, pa3);
    if (even) { MASKT(pB0, pB1, NT - 1); partialSM(pB0, pB1, m_reg, mnB, alB); __syncthreads(); RESC(alB);
        finishSM(pB0, pB1, alB, l_reg, pa0, pa1, pa2, pa3); SBAR(); pv_tile<1>(o, vb0, pa0, pa1, pa2, pa3); }
    SBAR(); SEAM_K0();
    if (hi == 0) li_l[r32] = l_reg; asm volatile("s_waitcnt lgkmcnt(0)" ::: "memory");
    float rli[16];
#pragma unroll
    for (int r = 0; r < 16; ++r) rli[r] = __builtin_amdgcn_rcpf(li_l[crow(r, hi)]);
    bf16* Ow = cur.O + (size_t)(wid * QBLK) * PITCH; const unsigned ooff = (unsigned)(4 * hi * PITCH + r32);
#pragma unroll
    for (int r = 0; r < 16; ++r) { const bf16* Or = Ow + (size_t)((r & 3) + 8 * (r >> 2)) * PITCH;
#pragma unroll
        for (int d0 = 0; d0 < 4; ++d0) { const float v = o[d0][r] * rli[r];
            const float vn = __shfl_xor(v, 1);
            if ((r32 & 1) == 0) *(unsigned*)(Or + ooff + d0 * 32) = cvtpk(v, vn); } }
    __syncthreads();
#undef RESC
#undef KBASE
#undef MASKT
#undef SEAM_K0
#undef HALF_STEP
}
#undef VMW
#undef VMWN
#undef SLOAD_H
#undef SWRITE_HK
#undef SWRITE_HV
#undef SWRITE_H
#undef KSWZ
#undef SBAR
}
constexpr int NWAVES = 8;
constexpr int DM = 2048, MP = 8192, MS = 32, MT = MP + MS, MPAD = 8448;
constexpr int AW = 1024, GW = 1024, NIN = 5120, NGATE = 4096, N1 = NIN + NGATE, FF = 5632, NF1 = 2 * FF, PLE = 256;
constexpr int SEQ = 2048, NH = 8, HD = 128;
constexpr int DECB = 8, DECS = 4, PAST = 16384, NPAGES = 128, NBLK_S = 64;
constexpr float EPS = 1e-6f;
constexpr int ROPE_ROWS = SEQ + DECS;
constexpr size_t OY_P = 0, OY_S = 16777216, OK_P = 16842752, OV_P = 25231360, OK_S = 33619968, OV_S = 33652736, OGV_S = 33685504, OUT_TOTAL = 33718272;

constexpr size_t MiB = 1u << 20;
constexpr size_t WS_CTL = 0, CTL_ZERO_BYTES = 64 * 1024;
constexpr size_t WS_W1T = 2 * MiB, WS_WAT = 38 * MiB, WS_WBT = 42 * MiB, WS_WOT = 46 * MiB, WS_WF1T = 54 * MiB, WS_WF2T = 98 * MiB, WS_WPGT = 120 * MiB, WS_WPLT = 128 * MiB;
constexpr size_t WS_ROPE = 129 * MiB, WS_KMS = 130 * MiB, WS_PBF = 132 * MiB, WS_H = 137 * MiB;
constexpr size_t WS_Q = 170 * MiB, WS_K = 187 * MiB, WS_V = 204 * MiB, WS_U = 221 * MiB, WS_VG = 238 * MiB;
constexpr size_t WS_GA = 255 * MiB, WS_GB = 288 * MiB, WS_ATT = 321 * MiB, WS_GM = 338 * MiB, WS_T = 355 * MiB, WS_MIXIN = 421 * MiB, WS_MIXF = 454 * MiB;
constexpr size_t WS_X1 = 520 * MiB, WS_XN1 = 586 * MiB, WS_HID = 619 * MiB, WS_X2 = 710 * MiB, WS_XN2 = 776 * MiB, WS_PW = 809 * MiB;
constexpr size_t WS_KMP = 842 * MiB;
constexpr size_t WS_RSP = 843 * MiB;
constexpr size_t WS_END = 846 * MiB;
constexpr int CW_TMO = 0, CW_CODE = 1, CW_BAR = 4096;

constexpr int RING_OFF = 0, RING_BYTES = 131072;
constexpr int LDSCTL_OFF = RING_BYTES, MISC_OFF = LDSCTL_OFF + 320;
constexpr int LDS_BYTES = 147456;

#define GAS __attribute__((address_space(1)))
#define LAS __attribute__((address_space(3)))
typedef unsigned short bf16;
typedef unsigned v4u __attribute__((ext_vector_type(4)));
typedef unsigned v2u __attribute__((ext_vector_type(2)));
typedef float f32x4 __attribute__((ext_vector_type(4)));
typedef float f32x16 __attribute__((ext_vector_type(16)));
typedef short bf16x8 __attribute__((ext_vector_type(8)));
typedef GAS unsigned gu32;
#define RLX_AGENT __ATOMIC_RELAXED, __HIP_MEMORY_SCOPE_AGENT
#define LDS_WAIT() asm volatile("s_waitcnt lgkmcnt(0)" ::: "memory")
#define VM_WAIT() asm volatile("s_waitcnt vmcnt(0)" ::: "memory")
__device__ __forceinline__ unsigned f2bf(float f) { unsigned u = __builtin_bit_cast(unsigned, f); return (u + 0x7fffu + ((u >> 16) & 1u)) >> 16; }
__device__ __forceinline__ unsigned pk2(float lo, float hi) { return f2bf(lo) | (f2bf(hi) << 16); }
__device__ __forceinline__ float bf2f(unsigned b) { return __uint_as_float(b << 16); }
__device__ __forceinline__ float bflo(unsigned w) { return __uint_as_float(w << 16); }
__device__ __forceinline__ float bfhi(unsigned w) { return __uint_as_float(w & 0xffff0000u); }
__device__ __forceinline__ float sigmoidf_(float x) { return __builtin_amdgcn_rcpf(1.f + __builtin_amdgcn_exp2f(-1.4426950408889634f * x)); }
__device__ __forceinline__ float gelu_tanh(float x) { const float z = 0.7978845608028654f * (x + 0.044715f * x * x * x); return x * __builtin_amdgcn_rcpf(1.f + __builtin_amdgcn_exp2f(-2.885390081777927f * z)); }
__device__ __forceinline__ float wave_sum(float v) {
#pragma unroll
    for (int o = 1; o < 64; o <<= 1) v += __shfl_xor(v, o);
    return v;
}
__device__ __forceinline__ float wave_max(float v) {
#pragma unroll
    for (int o = 1; o < 64; o <<= 1) v = fmaxf(v, __shfl_xor(v, o));
    return v;
}

#define XB_TMO      128
#define XB_XCNT(j)  (256  + 64 * (j))
#define XB_XSUB(j)  (1280 + 64 * (j))
#define XB_XGEN(j)  (2304 + 64 * (j))
#define XB_TOP      3328
#define XB_TOPGEN   3392
#define XCD_BAR_WORDS 3456
#define XB_SPIN_CAP (1u << 18)

__device__ __forceinline__ unsigned xb_ld(unsigned* p)              { return __hip_atomic_load(p, __ATOMIC_RELAXED, __HIP_MEMORY_SCOPE_AGENT); }
__device__ __forceinline__ unsigned xb_add(unsigned* p, unsigned v) { return __hip_atomic_fetch_add(p, v, __ATOMIC_RELAXED, __HIP_MEMORY_SCOPE_AGENT); }
__device__ __forceinline__ unsigned xb_xcc_id() { return (unsigned)__builtin_amdgcn_s_getreg((3 << 11) | 20) & 0xFu; }
#define XB_SPIN(cond, bar) do { unsigned _sp = 0; while (cond) { __builtin_amdgcn_s_sleep(1); \
    if ((++_sp & 255u) == 0u) { if (xb_ld(&(bar)[XB_TMO])) break; if (_sp > XB_SPIN_CAP) { atomicAdd(&(bar)[XB_TMO], 1u); break; } } } } while (0)

struct XcdBarrier {
    unsigned* bar; unsigned x;
    volatile LAS unsigned* st;
};

__device__ __forceinline__ XcdBarrier xcd_barrier_post(unsigned* bar, volatile LAS unsigned* st) {
    XcdBarrier b; b.bar = bar; b.x = xb_xcc_id(); b.st = st;
    if (threadIdx.x == 0) (void)xb_add(&bar[XB_XCNT(b.x)], 1u);
    return b;
}
__device__ __forceinline__ void xcd_barrier_complete(unsigned* bar, unsigned x, unsigned& nloc, unsigned& nx) {
    const unsigned G = gridDim.x * gridDim.y * gridDim.z;
    unsigned sum, cnt, mine, sp = 0u;
    for (;;) {
        sum = 0u; cnt = 0u; mine = 0u;
#pragma unroll
        for (unsigned j = 0; j < 16; ++j) { const unsigned c = xb_ld(&bar[XB_XCNT(j)]); sum += c; cnt += (c > 0u) ? 1u : 0u; mine = (j == x) ? c : mine; }
        if (sum == G) break;
        __builtin_amdgcn_s_sleep(1);
        if ((++sp & 255u) == 0u) { if (xb_ld(&bar[XB_TMO])) break; if (sp > XB_SPIN_CAP) { atomicAdd(&bar[XB_TMO], 1u); break; } }
    }
    nloc = mine > 0u ? mine : 1u; nx = cnt > 0u ? cnt : 1u;
}

__device__ __forceinline__ void xcd_barrier(const XcdBarrier& b) {
    asm volatile("s_waitcnt vmcnt(0)" ::: "memory");
    __syncthreads();
    if (threadIdx.x == 0) {
        unsigned* bar = b.bar;
        __builtin_amdgcn_s_waitcnt(0);
        unsigned nloc = b.st[0], nx = b.st[1];
        if (nloc == 0u) { xcd_barrier_complete(bar, b.x, nloc, nx); b.st[0] = nloc; b.st[1] = nx; }
        const unsigned old = xb_add(&bar[XB_XSUB(b.x)], 1u);
        const unsigned gen = old / nloc;
        if (old + 1u == (gen + 1u) * nloc) {
            __builtin_amdgcn_fence(__ATOMIC_RELEASE, "agent");
            asm volatile("s_waitcnt vmcnt(0)" ::: "memory");
            const unsigned og = xb_add(&bar[XB_TOP], 1u);
            const unsigned tg = og / nx;
            if (og + 1u == (tg + 1u) * nx) xb_add(&bar[XB_TOPGEN], 1u);
            else XB_SPIN(xb_ld(&bar[XB_TOPGEN]) == tg, bar);
            __builtin_amdgcn_fence(__ATOMIC_ACQUIRE, "agent");
            xb_add(&bar[XB_XGEN(b.x)], 1u);
            asm volatile("s_waitcnt vmcnt(0)" ::: "memory");
        } else {
            XB_SPIN(xb_ld(&bar[XB_XGEN(b.x)]) == gen, bar);
            __builtin_amdgcn_fence(__ATOMIC_ACQUIRE, "agent");
            asm volatile("s_waitcnt vmcnt(0)" ::: "memory");
        }
    }
    __syncthreads();
}
typedef pg8::f32x4 (accT)[2][2][4][2];
typedef float f32x2_t __attribute__((ext_vector_type(2))); typedef __bf16 bf16x2_t __attribute__((ext_vector_type(2)));
__device__ __forceinline__ unsigned cvtpk_c(float lo, float hi) { const f32x2_t v = {lo, hi}; const bf16x2_t b = __builtin_convertvector(v, bf16x2_t); return __builtin_bit_cast(unsigned, b); }
__device__ __forceinline__ void st_bf4(bf16* p, f32x4 v) { v2u w; w.x = cvtpk_c(v[0], v[1]); w.y = cvtpk_c(v[2], v[3]); *(v2u*)p = w; }
__device__ __forceinline__ f32x4 ld_bf4(const bf16* p) { const v2u w = *(const v2u*)p; return (f32x4){bflo(w.x), bfhi(w.x), bflo(w.y), bfhi(w.y)}; }
#define EPI_ROWS(ai, m) for (int ai = 0; ai < 2; ++ai) _Pragma("unroll") for (int m = 0; m < 4; ++m)
#define EPI_COLS(bj, n) for (int bj = 0; bj < 2; ++bj) _Pragma("unroll") for (int n = 0; n < 2; ++n)

struct EpiP1 {
    static constexpr bool PERM = false, AFTER_DRAIN = false;
    bf16 *Q, *K, *V, *U, *VG, *GA, *GB; float *ok, *ov; const float* rope; float* kmp; float* rsum; float* rsq;
    __device__ __forceinline__ void operator()(const accT& acc, const pg8::Unit& u, int wr, int wc, int fr, int fq) const {
        const int pn = u.pn, row0 = u.pm * 256 + wr * 64 + fr, cw = wc * 32 + 4 * fq;
        if (pn < 8) {
            const bool isK = pn >= 4; const int cbase = (pn & 3) * 256; bf16* dst = isK ? K : Q;
            f32x4 cs[2][2];
#pragma unroll
            for (int a = 0; a < 2; ++a)
#pragma unroll
                for (int b = 0; b < 2; ++b) cs[a][b] = (f32x4){0.f, 0.f, 0.f, 0.f};
#pragma unroll
            EPI_ROWS(ai, m) {
                const int row = row0 + ai * 128 + m * 16;
                f32x4 c4 = (f32x4){1.f, 1.f, 1.f, 1.f}, s4 = (f32x4){0.f, 0.f, 0.f, 0.f};
                if (wc == 0) { const float* rp = rope + (size_t)(row & (SEQ - 1)) * 32 + 4 * fq; c4 = *(const f32x4*)rp; s4 = *(const f32x4*)(rp + 16); }
#pragma unroll
                for (int bj = 0; bj < 2; ++bj) {
                    f32x4 v0 = acc[ai][bj][m][0], v1 = acc[ai][bj][m][1];
                    if (wc == 0) { const f32x4 r0 = v0 * c4 - v1 * s4, r1 = v1 * c4 + v0 * s4; v0 = r0; v1 = r1; }
                    const size_t off = (size_t)row * 1024 + cbase + bj * 128 + cw;
                    st_bf4(dst + off, v0); st_bf4(dst + off + 16, v1);
                    if (isK) { *(f32x4*)(ok + off) = v0; *(f32x4*)(ok + off + 16) = v1; cs[bj][0] += v0; cs[bj][1] += v1; }
                }
            }
            if (isK) {
#pragma unroll
                for (int bj = 0; bj < 2; ++bj)
#pragma unroll
                    for (int n = 0; n < 2; ++n) {
                        f32x4 s = cs[bj][n];
#pragma unroll
                        for (int o = 1; o < 16; o <<= 1) { s[0] += __shfl_xor(s[0], o); s[1] += __shfl_xor(s[1], o); s[2] += __shfl_xor(s[2], o); s[3] += __shfl_xor(s[3], o); }
                        if (fr == 0) *(f32x4*)(kmp + (size_t)(u.pm * 2 + wr) * 1024 + cbase + bj * 128 + cw + 16 * n) = s;
                    }
            }
        } else if (pn < 12) {
            const int cbase = (pn - 8) * 256;
#pragma unroll
            EPI_ROWS(ai, m) { const int row = row0 + ai * 128 + m * 16;
#pragma unroll
                EPI_COLS(bj, n) { const size_t off = (size_t)row * 1024 + cbase + bj * 128 + cw + 16 * n; const f32x4 v = acc[ai][bj][m][n]; st_bf4(V + off, v); *(f32x4*)(ov + off) = v; } }
        } else if (pn < 16) {
            const int cbase = (pn - 12) * 256;
#pragma unroll
            EPI_ROWS(ai, m) { const int row = row0 + ai * 128 + m * 16;
#pragma unroll
                EPI_COLS(bj, n) { const size_t off = (size_t)row * 1024 + cbase + bj * 128 + cw + 16 * n; const f32x4 v = acc[ai][bj][m][n];
                    st_bf4(U + off, (f32x4){gelu_tanh(v[0]), gelu_tanh(v[1]), gelu_tanh(v[2]), gelu_tanh(v[3])}); } }
        } else if (pn < 20) {
            const int cbase = (pn - 16) * 256;
#pragma unroll
            EPI_ROWS(ai, m) { const int row = row0 + ai * 128 + m * 16; float s = 0.f, q = 0.f;
#pragma unroll
                EPI_COLS(bj, n) { const size_t off = (size_t)row * 1024 + cbase + bj * 128 + cw + 16 * n; const f32x4 v = acc[ai][bj][m][n];
                    const f32x4 g = (f32x4){gelu_tanh(v[0]), gelu_tanh(v[1]), gelu_tanh(v[2]), gelu_tanh(v[3])};
                    st_bf4(VG + off, g); s += (g[0] + g[1]) + (g[2] + g[3]); q += (g[0] * g[0] + g[1] * g[1]) + (g[2] * g[2] + g[3] * g[3]); }
                s += __shfl_xor(s, 16); s += __shfl_xor(s, 32); q += __shfl_xor(q, 16); q += __shfl_xor(q, 32);
                if (fq == 0) { rsum[(size_t)row * 32 + (pn - 16) * 4 + wc] = s; rsq[(size_t)row * 32 + (pn - 16) * 4 + wc] = q; } }
        } else {
            bf16* dst = pn < 28 ? GA : GB; const int cbase = ((pn - 20) & 7) * 256;
#pragma unroll
            EPI_ROWS(ai, m) { const int row = row0 + ai * 128 + m * 16;
#pragma unroll
                EPI_COLS(bj, n) { const size_t off = (size_t)row * 2048 + cbase + bj * 128 + cw + 16 * n; const f32x4 v = acc[ai][bj][m][n];
                    st_bf4(dst + off, (f32x4){sigmoidf_(v[0]), sigmoidf_(v[1]), sigmoidf_(v[2]), sigmoidf_(v[3])}); } }
        }
    }
};
struct EpiBf {
    static constexpr bool PERM = false, AFTER_DRAIN = false; bf16* O; int ldc;
    __device__ __forceinline__ void operator()(const accT& acc, const pg8::Unit& u, int wr, int wc, int fr, int fq) const {
        const int row0 = u.pm * 256 + wr * 64 + fr, c0 = u.pn * 256 + wc * 32 + 4 * fq;
#pragma unroll
        EPI_ROWS(ai, m) { const int row = row0 + ai * 128 + m * 16;
#pragma unroll
            EPI_COLS(bj, n) st_bf4(O + (size_t)row * ldc + c0 + bj * 128 + 16 * n, acc[ai][bj][m][n]); }
    }
};
struct EpiF32 {
    static constexpr bool PERM = false, AFTER_DRAIN = false; float* O; int ldc;
    __device__ __forceinline__ void operator()(const accT& acc, const pg8::Unit& u, int wr, int wc, int fr, int fq) const {
        const int row0 = u.pm * 256 + wr * 64 + fr, c0 = u.pn * 256 + wc * 32 + 4 * fq;
#pragma unroll
        EPI_ROWS(ai, m) { const int row = row0 + ai * 128 + m * 16;
#pragma unroll
            EPI_COLS(bj, n) *(f32x4*)(O + (size_t)row * ldc + c0 + bj * 128 + 16 * n) = acc[ai][bj][m][n]; }
    }
};
struct EpiT {
    static constexpr bool PERM = false, AFTER_DRAIN = false; float* T; const bf16* GA;
    __device__ __forceinline__ void operator()(const accT& acc, const pg8::Unit& u, int wr, int wc, int fr, int fq) const {
        const int row0 = u.pm * 256 + wr * 64 + fr, c0 = u.pn * 256 + wc * 32 + 4 * fq;
#pragma unroll
        EPI_ROWS(ai, m) { const int row = row0 + ai * 128 + m * 16;
#pragma unroll
            EPI_COLS(bj, n) { const size_t off = (size_t)row * DM + c0 + bj * 128 + 16 * n; *(f32x4*)(T + off) = ld_bf4(GA + off) * acc[ai][bj][m][n]; } }
    }
};
struct EpiMix {
    static constexpr bool PERM = false, AFTER_DRAIN = false; const float* T; const bf16* GB; bf16* O;
    __device__ __forceinline__ void operator()(const accT& acc, const pg8::Unit& u, int wr, int wc, int fr, int fq) const {
        const int row0 = u.pm * 256 + wr * 64 + fr, c0 = u.pn * 256 + wc * 32 + 4 * fq;
#pragma unroll
        EPI_ROWS(ai, m) { const int row = row0 + ai * 128 + m * 16;
#pragma unroll
            EPI_COLS(bj, n) { const size_t off = (size_t)row * DM + c0 + bj * 128 + 16 * n; st_bf4(O + off, *(const f32x4*)(T + off) + ld_bf4(GB + off) * acc[ai][bj][m][n]); } }
    }
};
struct EpiSwiglu {
    static constexpr bool PERM = false, AFTER_DRAIN = false; bf16* O;
    __device__ __forceinline__ void operator()(const accT& acc, const pg8::Unit& u, int wr, int wc, int fr, int fq) const {
        const int row0 = u.pm * 256 + wr * 64 + fr, c0 = u.pn * 128 + wc * 32 + 4 * fq;
#pragma unroll
        EPI_ROWS(ai, m) { const int row = row0 + ai * 128 + m * 16;
#pragma unroll
            for (int n = 0; n < 2; ++n) { const f32x4 a = acc[ai][0][m][n], g = acc[ai][1][m][n];
                st_bf4(O + (size_t)row * FF + c0 + 16 * n, (f32x4){a[0] * sigmoidf_(a[0]) * g[0], a[1] * sigmoidf_(a[1]) * g[1], a[2] * sigmoidf_(a[2]) * g[2], a[3] * sigmoidf_(a[3]) * g[3]}); } }
    }
};
struct EpiY {
    static constexpr bool PERM = false, AFTER_DRAIN = false; const float* X2; const bf16* PW; float* Y;
    __device__ __forceinline__ void operator()(const accT& acc, const pg8::Unit& u, int wr, int wc, int fr, int fq) const {
        const int row0 = u.pm * 256 + wr * 64 + fr, c0 = u.pn * 256 + wc * 32 + 4 * fq;
#pragma unroll
        EPI_ROWS(ai, m) { const int row = row0 + ai * 128 + m * 16;
#pragma unroll
            EPI_COLS(bj, n) { const size_t off = (size_t)row * DM + c0 + bj * 128 + 16 * n; const f32x4 v = acc[ai][bj][m][n];
                *(f32x4*)(Y + off) = *(const f32x4*)(X2 + off) + ld_bf4(PW + off) * (f32x4){sigmoidf_(v[0]), sigmoidf_(v[1]), sigmoidf_(v[2]), sigmoidf_(v[3])}; } }
    }
};

__device__ __forceinline__ int crow32(int r, int hi) { return (r & 3) + 8 * (r >> 2) + 4 * hi; }
template <int BATCH, class E>
__device__ __forceinline__ void sample_gemm(LAS unsigned char* lds, const bf16* A, const bf16* Bt, int N, int K, int cu, int ncu, const E& epi) {
    const int tid = threadIdx.x, wave = __builtin_amdgcn_readfirstlane(tid >> 6), lane = tid & 63, r32 = lane & 31, hi = lane >> 5;
    LAS float* red = (LAS float*)lds; LAS float* tile = (LAS float*)(lds + 32768);
    const int kslice = K >> 3, nsteps = kslice >> 4;
    for (int ut = cu; ut < (N >> 5); ut += ncu) {
        f32x16 acc = {};
        const bf16* ap = A + (size_t)r32 * K + wave * kslice + hi * 8;
        const bf16* bp = Bt + (size_t)(ut * 32 + r32) * K + wave * kslice + hi * 8;
        for (int s = 0; s < nsteps; s += BATCH) {
            bf16x8 a[BATCH], b[BATCH];
#pragma unroll
            for (int i = 0; i < BATCH; ++i) { a[i] = *(const bf16x8*)(ap + (s + i) * 16); b[i] = *(const bf16x8*)(bp + (s + i) * 16); }
#pragma unroll
            for (int i = 0; i < BATCH; ++i) acc = __builtin_amdgcn_mfma_f32_32x32x16_bf16(a[i], b[i], acc, 0, 0, 0);
        }
#pragma unroll
        for (int r = 0; r < 16; ++r) red[wave * 1024 + crow32(r, hi) * 32 + r32] = acc[r];
        __syncthreads();
#pragma unroll
        for (int e2 = 0; e2 < 2; ++e2) { const int e = tid + 512 * e2; float s = 0.f;
#pragma unroll
            for (int w = 0; w < 8; ++w) s += red[w * 1024 + e];
            tile[(e >> 5) * 33 + (e & 31)] = s; }
        __syncthreads();
        epi(tile, ut, tid);
        __syncthreads();
    }
}
template <class E>
__device__ __forceinline__ void sample_gemm_swiglu(LAS unsigned char* lds, const bf16* A, const bf16* Bt, int K, int cu, int ncu, const E& epi) {
    const int tid = threadIdx.x, wave = __builtin_amdgcn_readfirstlane(tid >> 6), lane = tid & 63, r32 = lane & 31, hi = lane >> 5;
    LAS float* red = (LAS float*)lds; LAS float* tile = (LAS float*)(lds + 65536);
    const int kslice = K >> 3, nsteps = kslice >> 4;
    for (int ut = cu; ut < (FF >> 5); ut += ncu) {
        const int j0 = ut * 32, ra = 256 * (j0 >> 7) + (j0 & 127);
        f32x16 acca = {}, accg = {};
        const bf16* ap = A + (size_t)r32 * K + wave * kslice + hi * 8;
        const bf16* bp = Bt + (size_t)(ra + r32) * K + wave * kslice + hi * 8;
        const bf16* gp = bp + (size_t)128 * K;
        for (int s = 0; s < nsteps; s += 4) {
            bf16x8 a[4], b[4], g[4];
#pragma unroll
            for (int i = 0; i < 4; ++i) { a[i] = *(const bf16x8*)(ap + (s + i) * 16); b[i] = *(const bf16x8*)(bp + (s + i) * 16); g[i] = *(const bf16x8*)(gp + (s + i) * 16); }
#pragma unroll
            for (int i = 0; i < 4; ++i) { acca = __builtin_amdgcn_mfma_f32_32x32x16_bf16(a[i], b[i], acca, 0, 0, 0); accg = __builtin_amdgcn_mfma_f32_32x32x16_bf16(a[i], g[i], accg, 0, 0, 0); }
        }
#pragma unroll
        for (int r = 0; r < 16; ++r) { red[wave * 2048 + crow32(r, hi) * 32 + r32] = acca[r]; red[wave * 2048 + 1024 + crow32(r, hi) * 32 + r32] = accg[r]; }
        __syncthreads();
#pragma unroll
        for (int e2 = 0; e2 < 4; ++e2) { const int e = tid + 512 * e2; float s = 0.f;
#pragma unroll
            for (int w = 0; w < 8; ++w) s += red[w * 2048 + e];
            tile[(e >> 10) * 1056 + ((e & 1023) >> 5) * 33 + (e & 31)] = s; }
        __syncthreads();
        epi(tile, ut, tid);
        __syncthreads();
    }
}
#define SE_ELEMS(e, sr, cc) for (int e2_ = 0; e2_ < 2; ++e2_) { const int e = tid + 512 * e2_, sr = e >> 5, cc = e & 31;
struct SEpiP1 {
    bf16 *Q, *K, *V, *U, *VG, *GA, *GB; float *oks, *ovs; const float* rope; float* rsum; float* rsq;
    __device__ __forceinline__ void operator()(const LAS float* tile, int ut, int tid) const {
        const int c0 = ut * 32;
#pragma unroll
        SE_ELEMS(e, sr, cc)
            const int c = c0 + cc; const size_t r = MP + sr; const float val = tile[sr * 33 + cc];
            if (c0 < 2048) {
                const bool isK = c0 >= 1024; const int c1 = c & 1023, d = c1 & 127; float o = val;
                if (d < 32) { const float* rp = rope + (size_t)(SEQ + (sr & 3)) * 32 + (d & 15); const float cs = rp[0], sn = rp[16];
                    o = (d < 16) ? val * cs - tile[sr * 33 + cc + 16] * sn : val * cs + tile[sr * 33 + cc - 16] * sn; }
                if (isK) { K[r * 1024 + c1] = (bf16)f2bf(o); oks[(size_t)sr * 1024 + c1] = o; } else Q[r * 1024 + c1] = (bf16)f2bf(o);
            } else if (c0 < 3072) { const int c1 = c - 2048; V[r * 1024 + c1] = (bf16)f2bf(val); ovs[(size_t)sr * 1024 + c1] = val; }
            else if (c0 < 4096) { U[r * 1024 + (c - 3072)] = (bf16)f2bf(gelu_tanh(val)); }
            else if (c0 < 5120) { const float g = gelu_tanh(val); VG[r * 1024 + (c - 4096)] = (bf16)f2bf(g);
                float s = g, q = g * g;
#pragma unroll
                for (int o = 1; o < 32; o <<= 1) { s += __shfl_xor(s, o); q += __shfl_xor(q, o); }
                if (cc == 0) { rsum[r * 32 + (ut - 128)] = s; rsq[r * 32 + (ut - 128)] = q; } }
            else if (c0 < 7168) GA[r * 2048 + (c - 5120)] = (bf16)f2bf(sigmoidf_(val));
            else GB[r * 2048 + (c - 7168)] = (bf16)f2bf(sigmoidf_(val));
        }
    }
};
struct SEpiBf { bf16* O; int ldc;
    __device__ __forceinline__ void operator()(const LAS float* tile, int ut, int tid) const {
#pragma unroll
        SE_ELEMS(e, sr, cc) O[(size_t)(MP + sr) * ldc + ut * 32 + cc] = (bf16)f2bf(tile[sr * 33 + cc]); } } };
struct SEpiF32 { float* O; int ldc;
    __device__ __forceinline__ void operator()(const LAS float* tile, int ut, int tid) const {
#pragma unroll
        SE_ELEMS(e, sr, cc) O[(size_t)(MP + sr) * ldc + ut * 32 + cc] = tile[sr * 33 + cc]; } } };
struct SEpiT { float* T; const bf16* GA;
    __device__ __forceinline__ void operator()(const LAS float* tile, int ut, int tid) const {
#pragma unroll
        SE_ELEMS(e, sr, cc) const size_t off = (size_t)(MP + sr) * DM + ut * 32 + cc; T[off] = bf2f(GA[off]) * tile[sr * 33 + cc]; } } };
struct SEpiMix { const float* T; const bf16* GB; bf16* O;
    __device__ __forceinline__ void operator()(const LAS float* tile, int ut, int tid) const {
#pragma unroll
        SE_ELEMS(e, sr, cc) const size_t off = (size_t)(MP + sr) * DM + ut * 32 + cc; O[off] = (bf16)f2bf(T[off] + bf2f(GB[off]) * tile[sr * 33 + cc]); } } };
struct SEpiSwiglu { bf16* O;
    __device__ __forceinline__ void operator()(const LAS float* tile, int ut, int tid) const {
#pragma unroll
        SE_ELEMS(e, sr, cc) const float a = tile[sr * 33 + cc], g = tile[1056 + sr * 33 + cc]; O[(size_t)(MP + sr) * FF + ut * 32 + cc] = (bf16)f2bf(a * sigmoidf_(a) * g); } } };
struct SEpiY { const float* X2; const bf16* PW; float* Ys;
    __device__ __forceinline__ void operator()(const LAS float* tile, int ut, int tid) const {
#pragma unroll
        SE_ELEMS(e, sr, cc) const size_t off = (size_t)(MP + sr) * DM + ut * 32 + cc; Ys[(size_t)sr * DM + ut * 32 + cc] = X2[off] + bf2f(PW[off]) * sigmoidf_(tile[sr * 33 + cc]); } } };

__device__ __forceinline__ void tr_item(const float* W, int K, int N, bf16* WT, int k0, int n0, int drow0, LAS float* scr, int lane) {
#pragma unroll 8
    for (int i = 0; i < 32; ++i) { const int kk = 2 * i + (lane >> 5); scr[kk * 33 + (lane & 31)] = W[(size_t)(k0 + kk) * N + n0 + (lane & 31)]; }
    LDS_WAIT(); asm volatile("" ::: "memory");
    const int c = lane & 7;
#pragma unroll
    for (int j = 0; j < 4; ++j) { const int n = (lane >> 3) + 8 * j; const LAS float* s = scr + (8 * c) * 33 + n;
        v4u o; o.x = pk2(s[0 * 33], s[1 * 33]); o.y = pk2(s[2 * 33], s[3 * 33]); o.z = pk2(s[4 * 33], s[5 * 33]); o.w = pk2(s[6 * 33], s[7 * 33]);
        *(GAS v4u*)(WT + (size_t)(drow0 + n) * K + k0 + 8 * c) = o; }
    LDS_WAIT(); asm volatile("" ::: "memory");
}
__device__ __forceinline__ void rms_row_bf16(const float* xrow, const float* g, bf16* orow, int lane) {
    const f32x4* xr = (const f32x4*)xrow + lane; const f32x4* gr = (const f32x4*)g + lane;
    f32x4 v[8]; float ss = 0.f;
#pragma unroll
    for (int j = 0; j < 8; ++j) { v[j] = xr[64 * j]; ss += (v[j][0] * v[j][0] + v[j][1] * v[j][1]) + (v[j][2] * v[j][2] + v[j][3] * v[j][3]); }
    const float rstd = 1.0f / sqrtf(wave_sum(ss) * (1.f / DM) + EPS);
    v2u* o8 = (v2u*)orow + lane;
#pragma unroll
    for (int j = 0; j < 8; ++j) { const f32x4 gg = gr[64 * j]; v2u w; w.x = pk2(v[j][0] * rstd * gg[0], v[j][1] * rstd * gg[1]); w.y = pk2(v[j][2] * rstd * gg[2], v[j][3] * rstd * gg[3]); o8[64 * j] = w; }
}
__device__ __forceinline__ void norm_residual_row(const float* frow, const float* xi, const float* g1, float* xo, const float* g2, bf16* xn, int lane) {
    const f32x4* fr = (const f32x4*)frow + lane; const f32x4* xr = (const f32x4*)xi + lane;
    f32x4 v[8]; float ss = 0.f;
#pragma unroll
    for (int j = 0; j < 8; ++j) { v[j] = fr[64 * j]; ss += (v[j][0] * v[j][0] + v[j][1] * v[j][1]) + (v[j][2] * v[j][2] + v[j][3] * v[j][3]); }
    const float rstd = 1.0f / sqrtf(wave_sum(ss) * (1.f / DM) + EPS);
    float s2 = 0.f;
#pragma unroll
    for (int j = 0; j < 8; ++j) { const f32x4 gg = ((const f32x4*)g1 + lane)[64 * j]; v[j] = xr[64 * j] + v[j] * rstd * gg; ((f32x4*)xo + lane)[64 * j] = v[j];
        s2 += (v[j][0] * v[j][0] + v[j][1] * v[j][1]) + (v[j][2] * v[j][2] + v[j][3] * v[j][3]); }
    const float rstd2 = 1.0f / sqrtf(wave_sum(s2) * (1.f / DM) + EPS);
    v2u* o8 = (v2u*)xn + lane;
#pragma unroll
    for (int j = 0; j < 8; ++j) { const f32x4 gg = ((const f32x4*)g2 + lane)[64 * j]; v2u w; w.x = pk2(v[j][0] * rstd2 * gg[0], v[j][1] * rstd2 * gg[1]); w.y = pk2(v[j][2] * rstd2 * gg[2], v[j][3] * rstd2 * gg[3]); o8[64 * j] = w; }
}

__device__ __forceinline__ void gmlp_unit(LAS unsigned char* lds, int unit, const bf16* U, const bf16* VG, const float* rsum, const float* rsq, const float* gvn,
                                          const float* Wsp, const float* bsp, bf16* GM) {
    const int tid = threadIdx.x, wave = __builtin_amdgcn_readfirstlane(tid >> 6), lane = tid & 63, r32 = lane & 31, hi = lane >> 5;
    const int g = unit & 7, bc = unit >> 3;
    const size_t R0 = (size_t)bc * 128; const int C0 = g * 128;
    LAS bf16* vnT = (LAS bf16*)lds;
    {
        const int s = tid & 127, dq = tid >> 7; const size_t row = R0 + s;
        float sm = 0.f, sq = 0.f;
#pragma unroll
        for (int i = 0; i < 4; ++i) { const f32x4 a = *(const f32x4*)(rsum + row * 32 + 4 * i), b = *(const f32x4*)(rsq + row * 32 + 4 * i);
            sm += (a[0] + a[1]) + (a[2] + a[3]); sq += (b[0] + b[1]) + (b[2] + b[3]); }
        const float mu = sm * (1.f / GW), var = sq * (1.f / GW) - mu * mu, rstd = 1.0f / sqrtf(var + EPS);
        const bf16* src = VG + row * 1024 + C0 + dq * 32; const float* gp = gvn + C0 + dq * 32;
#pragma unroll
        for (int i = 0; i < 4; ++i) { const v4u w = *(const v4u*)(src + 8 * i); const f32x4 g0 = *(const f32x4*)(gp + 8 * i), g1 = *(const f32x4*)(gp + 8 * i + 4);
            const int d = dq * 32 + 8 * i;
            vnT[(d + 0) * 136 + s] = (bf16)f2bf((bflo(w.x) - mu) * rstd * g0[0]); vnT[(d + 1) * 136 + s] = (bf16)f2bf((bfhi(w.x) - mu) * rstd * g0[1]);
            vnT[(d + 2) * 136 + s] = (bf16)f2bf((bflo(w.y) - mu) * rstd * g0[2]); vnT[(d + 3) * 136 + s] = (bf16)f2bf((bfhi(w.y) - mu) * rstd * g0[3]);
            vnT[(d + 4) * 136 + s] = (bf16)f2bf((bflo(w.z) - mu) * rstd * g1[0]); vnT[(d + 5) * 136 + s] = (bf16)f2bf((bfhi(w.z) - mu) * rstd * g1[1]);
            vnT[(d + 6) * 136 + s] = (bf16)f2bf((bflo(w.w) - mu) * rstd * g1[2]); vnT[(d + 7) * 136 + s] = (bf16)f2bf((bfhi(w.w) - mu) * rstd * g1[3]); }
    }
    __syncthreads();
    const int ti = wave >> 1, dbase = (wave & 1) * 64;
    f32x16 acc0 = {}, acc1 = {};
    const int t = ti * 32 + r32; const float* wrow = Wsp + ((size_t)g * 128 + t) * 128;
    for (int ks = 0; ks < 2 * ti + 2; ++ks) {
        const int s0 = ks * 16 + hi * 8;
        const f32x4 w0 = *(const f32x4*)(wrow + s0), w1 = *(const f32x4*)(wrow + s0 + 4);
        v4u aw; aw.x = pk2(s0 + 0 <= t ? w0[0] : 0.f, s0 + 1 <= t ? w0[1] : 0.f); aw.y = pk2(s0 + 2 <= t ? w0[2] : 0.f, s0 + 3 <= t ? w0[3] : 0.f);
        aw.z = pk2(s0 + 4 <= t ? w1[0] : 0.f, s0 + 5 <= t ? w1[1] : 0.f); aw.w = pk2(s0 + 6 <= t ? w1[2] : 0.f, s0 + 7 <= t ? w1[3] : 0.f);
        const bf16x8 a = __builtin_bit_cast(bf16x8, aw);
        const bf16x8 b0 = *(const LAS bf16x8*)(vnT + (dbase + r32) * 136 + s0), b1 = *(const LAS bf16x8*)(vnT + (dbase + 32 + r32) * 136 + s0);
        acc0 = __builtin_amdgcn_mfma_f32_32x32x16_bf16(a, b0, acc0, 0, 0, 0);
        acc1 = __builtin_amdgcn_mfma_f32_32x32x16_bf16(a, b1, acc1, 0, 0, 0);
    }
#pragma unroll
    for (int r = 0; r < 16; ++r) { const int tt = ti * 32 + crow32(r, hi); const float bias = bsp[g * 128 + tt];
        const size_t o0 = (R0 + tt) * 1024 + C0 + dbase + r32;
        GM[o0] = (bf16)f2bf(bf2f(U[o0]) * (acc0[r] + bias)); GM[o0 + 32] = (bf16)f2bf(bf2f(U[o0 + 32]) * (acc1[r] + bias)); }
    __syncthreads();
}
__device__ __forceinline__ void sattn_unit(LAS unsigned char* lds, int unit, const bf16* Q, const float* kms, const float* ck, const float* cv, const int* pt,
                                           const float* knew, const float* vnew, bf16* ATT) {
    const int tid = threadIdx.x, lane = tid & 63, hw = tid >> 5, l32 = tid & 31;
    const int qi = unit & 3, h = (unit >> 2) & 7, db = unit >> 5;
    LAS float* qs = (LAS float*)lds;
    LAS float* gate = qs + 128;
    LAS int* sel = (LAS int*)(gate + 64);
    LAS float* sc = (LAS float*)(sel + 4);
    LAS float* redv = sc + 776;
    LAS float* stat = redv + 2048;
    const size_t qrow = MP + db * 4 + qi;
    if (tid < 128) qs[tid] = bf2f(Q[qrow * 1024 + h * 128 + tid]);
    __syncthreads();
    {
        const int n = tid >> 3, part = tid & 7; const float* km = kms + ((size_t)(db * 64 + n)) * 1024 + h * 128 + part * 16; float s = 0.f;
#pragma unroll
        for (int i = 0; i < 4; ++i) { const f32x4 k4 = *(const f32x4*)(km + 4 * i); s += qs[part * 16 + 4 * i] * k4[0] + qs[part * 16 + 4 * i + 1] * k4[1] + qs[part * 16 + 4 * i + 2] * k4[2] + qs[part * 16 + 4 * i + 3] * k4[3]; }
        s += __shfl_xor(s, 1); s += __shfl_xor(s, 2); s += __shfl_xor(s, 4);
        if (part == 0) gate[n] = s;
    }
    __syncthreads();
    if (tid < 64) {
        float v = gate[lane];
#pragma unroll
        for (int it = 0; it < 3; ++it) { const float m = wave_max(v); const unsigned long long bal = __ballot(v == m); const int idx = __ffsll((long long)bal) - 1;
            if (lane == 0) sel[it] = idx; if (lane == idx) v = -3.0e38f; }
    }
    __syncthreads();
    const float scale = 0.08838834764831845f;
    const f32x4 q4 = *(const LAS f32x4*)(qs + l32 * 4);
#pragma unroll 4
    for (int i = 0; i < 48; ++i) { const int kk = hw + 16 * i, slot = kk >> 8, j = kk & 255; const int blk = sel[slot];
        const int page = pt[db * NPAGES + 2 * blk + (j >> 7)];
        const f32x4 k4 = __builtin_nontemporal_load((const f32x4*)(ck + (((size_t)page * 128 + (j & 127)) * 8 + h) * 128) + l32);
        float s = q4[0] * k4[0] + q4[1] * k4[1] + q4[2] * k4[2] + q4[3] * k4[3];
        s += __shfl_xor(s, 1); s += __shfl_xor(s, 2); s += __shfl_xor(s, 4); s += __shfl_xor(s, 8); s += __shfl_xor(s, 16);
        if (l32 == 0) sc[kk] = s * scale; }
    if (hw <= qi) { const f32x4 k4 = *((const f32x4*)(knew + ((size_t)(db * 4 + hw)) * 1024 + h * 128) + l32);
        float s = q4[0] * k4[0] + q4[1] * k4[1] + q4[2] * k4[2] + q4[3] * k4[3];
        s += __shfl_xor(s, 1); s += __shfl_xor(s, 2); s += __shfl_xor(s, 4); s += __shfl_xor(s, 8); s += __shfl_xor(s, 16);
        if (l32 == 0) sc[768 + hw] = s * scale; }
    __syncthreads();
    const int nk = 768 + qi + 1;
    {
        float m = -3.0e38f; for (int k = tid; k < nk; k += 512) m = fmaxf(m, sc[k]);
        m = wave_max(m); if (lane == 0) stat[tid >> 6] = m;
        __syncthreads();
        float mm = stat[0];
#pragma unroll
        for (int w = 1; w < 8; ++w) mm = fmaxf(mm, stat[w]);
        float s = 0.f; for (int k = tid; k < nk; k += 512) { const float p = __expf(sc[k] - mm); sc[k] = p; s += p; }
        s = wave_sum(s); if (lane == 0) stat[8 + (tid >> 6)] = s;
        __syncthreads();
    }
    float tot = 0.f;
#pragma unroll
    for (int w = 0; w < 8; ++w) tot += stat[8 + w];
    f32x4 o4 = (f32x4){0.f, 0.f, 0.f, 0.f};
#pragma unroll 4
    for (int i = 0; i < 48; ++i) { const int kk = hw + 16 * i, slot = kk >> 8, j = kk & 255; const int blk = sel[slot];
        const int page = pt[db * NPAGES + 2 * blk + (j >> 7)];
        const f32x4 v4 = __builtin_nontemporal_load((const f32x4*)(cv + (((size_t)page * 128 + (j & 127)) * 8 + h) * 128) + l32);
        o4 += v4 * sc[kk]; }
    if (hw <= qi) { const f32x4 v4 = *((const f32x4*)(vnew + ((size_t)(db * 4 + hw)) * 1024 + h * 128) + l32); o4 += v4 * sc[768 + hw]; }
    *(LAS f32x4*)(redv + hw * 128 + l32 * 4) = o4;
    __syncthreads();
    if (tid < 128) { float s = 0.f;
#pragma unroll
        for (int w = 0; w < 16; ++w) s += redv[w * 128 + tid];
        ATT[qrow * 1024 + h * 128 + tid] = (bf16)f2bf(s / tot); }
    __syncthreads();
}
__device__ __forceinline__ void sgmlp_all(const bf16* U, const bf16* VG, const float* rsum, const float* rsq, const float* gvn, const float* Wsp, const float* bsp, bf16* GM, float* gv_out) {
    const int tid = threadIdx.x;
    for (int ch = tid; ch < GW; ch += 512) {
        const int g = ch >> 7; const float gv = gvn[ch];
        for (int db = 0; db < DECB; ++db) {
            float vn[4];
#pragma unroll
            for (int s = 0; s < 4; ++s) { const size_t row = MP + db * 4 + s; float sm = 0.f, sq = 0.f;
                for (int i = 0; i < 32; ++i) { sm += rsum[row * 32 + i]; sq += rsq[row * 32 + i]; }
                const float mu = sm * (1.f / GW), var = sq * (1.f / GW) - mu * mu, rstd = 1.0f / sqrtf(var + EPS);
                vn[s] = (bf2f(VG[row * 1024 + ch]) - mu) * rstd * gv; gv_out[(size_t)(db * 4 + s) * 1024 + ch] = vn[s]; }
#pragma unroll
            for (int t = 0; t < 4; ++t) { float s = bsp[g * 128 + t];
#pragma unroll
                for (int k = 0; k < 4; ++k) if (k <= t) s += Wsp[((size_t)g * 128 + t) * 128 + k] * vn[k];
                const size_t o = (size_t)(MP + db * 4 + t) * 1024 + ch; GM[o] = (bf16)f2bf(bf2f(U[o]) * s); }
        }
    }
}

#ifndef PH0
#define PH0 1
#endif
#ifndef PH1
#define PH1 1
#endif
#ifndef PH2
#define PH2 1
#endif
#ifndef PH3
#define PH3 1
#endif
#ifndef PH4
#define PH4 1
#endif
#ifndef PH5
#define PH5 1
#endif
#ifndef PH6
#define PH6 1
#endif
#ifndef PH7
#define PH7 1
#endif
#ifndef PH8
#define PH8 1
#endif
#ifndef PH9
#define PH9 1
#endif
#ifndef PH10
#define PH10 1
#endif
struct Args { const void* in[24]; float* out; unsigned char* ws; int ph_lo, ph_hi; };
constexpr int N_PHASES = 11;
__global__ void __launch_bounds__(NWAVES * 64, 2) moba_fwd(Args args) {
    extern __shared__ __attribute__((aligned(16))) unsigned char lds_raw[];
    LAS unsigned char* lds = (LAS unsigned char*)lds_raw;
    const int tid = threadIdx.x, lane = tid & 63, wave = __builtin_amdgcn_readfirstlane(tid >> 6);
    const int G = gridDim.x, bx = blockIdx.x;
    const int vcu = (G % 8 == 0) ? (bx % 8) * (G / 8) + bx / 8 : bx;
    gu32* ctl = (gu32*)(args.ws + WS_CTL);
#define x_p ((const float*)INP(0))
#define x_s ((const float*)INP(1))
#define cache_k ((const float*)INP(2))
#define cache_v ((const float*)INP(3))
#define ptab ((const int*)INP(4))
#define p_p ((const float*)INP(5))
#define p_s ((const float*)INP(6))
#define g_pre ((const float*)INP(7))
#define w_in ((const float*)INP(8))
#define g_vn ((const float*)INP(9))
#define w_sp ((const float*)INP(10))
#define b_sp ((const float*)INP(11))
#define w_a ((const float*)INP(12))
#define w_b ((const float*)INP(13))
#define w_gate ((const float*)INP(14))
#define w_o ((const float*)INP(15))
#define g_post_mix ((const float*)INP(16))
#define g_pre_ffn ((const float*)INP(17))
#define w_f1 ((const float*)INP(18))
#define w_f2 ((const float*)INP(19))
#define g_post_ffn ((const float*)INP(20))
#define g_ple ((const float*)INP(21))
#define w_pg ((const float*)INP(22))
#define w_pl ((const float*)INP(23))
#define W1T ((bf16*)(WSP + WS_W1T))
#define WAT ((bf16*)(WSP + WS_WAT))
#define WBT ((bf16*)(WSP + WS_WBT))
#define WOT ((bf16*)(WSP + WS_WOT))
#define WF1T ((bf16*)(WSP + WS_WF1T))
#define WF2T ((bf16*)(WSP + WS_WF2T))
#define WPGT ((bf16*)(WSP + WS_WPGT))
#define WPLT ((bf16*)(WSP + WS_WPLT))
#define ROPE ((float*)(WSP + WS_ROPE))
#define KMS ((float*)(WSP + WS_KMS))
#define PBF ((bf16*)(WSP + WS_PBF))
#define Hb ((bf16*)(WSP + WS_H))
#define Qb ((bf16*)(WSP + WS_Q))
#define Kb ((bf16*)(WSP + WS_K))
#define Vb ((bf16*)(WSP + WS_V))
#define Ub ((bf16*)(WSP + WS_U))
#define VGb ((bf16*)(WSP + WS_VG))
#define GAb ((bf16*)(WSP + WS_GA))
#define GBb ((bf16*)(WSP + WS_GB))
#define ATTb ((bf16*)(WSP + WS_ATT))
#define GMb ((bf16*)(WSP + WS_GM))
#define Tf ((float*)(WSP + WS_T))
#define MIXINb ((bf16*)(WSP + WS_MIXIN))
#define MIXF ((float*)(WSP + WS_MIXF))
#define X1 ((float*)(WSP + WS_X1))
#define XN1 ((bf16*)(WSP + WS_XN1))
#define HIDb ((bf16*)(WSP + WS_HID))
#define X2 ((float*)(WSP + WS_X2))
#define XN2 ((bf16*)(WSP + WS_XN2))
#define PWb ((bf16*)(WSP + WS_PW))
#define KMP ((float*)(WSP + WS_KMP))
#define RSUM ((float*)(WSP + WS_RSP))
#define RSQ (RSUM + (size_t)MPAD * 32)
    for (int u = tid; u < (LDS_BYTES - LDSCTL_OFF) / 4; u += NWAVES * 64) ((LAS unsigned*)(lds + LDSCTL_OFF))[u] = 0u;
    __syncthreads();
    volatile LAS unsigned* MISC = (volatile LAS unsigned*)(lds + MISC_OFF);
    const int lo = args.ph_lo, hi_ph = args.ph_hi;
    XcdBarrier bar; bar.bar = (unsigned*)(ctl + CW_BAR); bar.x = 0; bar.st = nullptr;
    if (hi_ph - lo > 1) bar = xcd_barrier_post((unsigned*)(ctl + CW_BAR), MISC + 8);
#define IN(k) (lo <= (k) && (k) < hi_ph)
#define PHASE_BASES() const char __attribute__((address_space(4)))* kargp = (const char __attribute__((address_space(4)))*)__builtin_amdgcn_kernarg_segment_ptr(); asm volatile("" : "+s"(kargp)); \
    unsigned char* WSP = *(unsigned char* const __attribute__((address_space(4)))*)(kargp + 200); float* OUTP = *(float* const __attribute__((address_space(4)))*)(kargp + 192)
#define INP(k) (*(const void* const __attribute__((address_space(4)))*)(kargp + 8 * (k)))
#define SEAM(k) do { if (IN(k) && IN((k) + 1)) xcd_barrier(bar); } while (0)
    const int gw = vcu * NWAVES + wave, NGW = G * NWAVES;

    if (PH0 && IN(0)) { PHASE_BASES();
        for (int it = bx; it < DECB * NBLK_S; it += G) {
            const int db = it >> 6, blk = it & 63; const int c4 = tid & 255, rh = tid >> 8;
            f32x4 a = (f32x4){0.f, 0.f, 0.f, 0.f};
#pragma unroll
            for (int pg = 0; pg < 2; ++pg) { const int page = ptab[db * NPAGES + 2 * blk + pg]; const f32x4* base = (const f32x4*)(cache_k + (size_t)page * 128 * 1024) + c4;
#pragma unroll 8
                for (int r = rh; r < 128; r += 2) a += __builtin_nontemporal_load(base + (size_t)r * 256); }
            LAS f32x4* red = (LAS f32x4*)lds;
            if (rh == 1) red[c4] = a;
            __syncthreads();
            if (rh == 0) { const f32x4 b = red[c4]; *(f32x4*)(KMS + (size_t)it * 1024 + c4 * 4) = (a + b) * (1.f / 256.f); }
            __syncthreads();
        }
        {
            LAS float* scr = (LAS float*)(lds + RING_OFF + wave * 16384);
            constexpr int I0 = 32 * 160, I1 = 32 * 128, I2 = 16 * 64, I3 = 16 * 64, I4 = 32 * 64, I5 = 32 * 352, I6 = 88 * 64, I7 = 32 * 64, I8 = 4 * 64;
            constexpr int NITEMS = I0 + I1 + I2 + I3 + I4 + I5 + I6 + I7 + I8;
            for (int it = gw; it < NITEMS; it += NGW) {
                int r = it;
                if (r < I0) { tr_item(w_in, DM, NIN, W1T, 64 * (r / 160), 32 * (r % 160), 32 * (r % 160), scr, lane); continue; } r -= I0;
                if (r < I1) { tr_item(w_gate, DM, NGATE, W1T, 64 * (r / 128), 32 * (r % 128), NIN + 32 * (r % 128), scr, lane); continue; } r -= I1;
                if (r < I2) { tr_item(w_a, AW, DM, WAT, 64 * (r / 64), 32 * (r % 64), 32 * (r % 64), scr, lane); continue; } r -= I2;
                if (r < I3) { tr_item(w_b, GW, DM, WBT, 64 * (r / 64), 32 * (r % 64), 32 * (r % 64), scr, lane); continue; } r -= I3;
                if (r < I4) { tr_item(w_o, DM, DM, WOT, 64 * (r / 64), 32 * (r % 64), 32 * (r % 64), scr, lane); continue; } r -= I4;
                if (r < I5) { const int n0 = 32 * (r % 352); const int dr = n0 < FF ? 256 * (n0 >> 7) + (n0 & 127) : 256 * ((n0 - FF) >> 7) + 128 + ((n0 - FF) & 127);
                              tr_item(w_f1, DM, NF1, WF1T, 64 * (r / 352), n0, dr, scr, lane); continue; } r -= I5;
                if (r < I6) { tr_item(w_f2, FF, DM, WF2T, 64 * (r / 64), 32 * (r % 64), 32 * (r % 64), scr, lane); continue; } r -= I6;
                if (r < I7) { tr_item(w_pg, DM, DM, WPGT, 64 * (r / 64), 32 * (r % 64), 32 * (r % 64), scr, lane); continue; } r -= I7;
                tr_item(w_pl, PLE, DM, WPLT, 64 * (r / 64), 32 * (r % 64), 32 * (r % 64), scr, lane);
            }
        }
        for (int m = gw; m < MT; m += NGW) {
            const float* xr = m < MP ? x_p + (size_t)m * DM : x_s + (size_t)(m - MP) * DM;
            rms_row_bf16(xr, g_pre, Hb + (size_t)m * DM, lane);
            const float* pr = m < MP ? p_p + (size_t)m * PLE : p_s + (size_t)(m - MP) * PLE;
            const f32x4 v = ((const f32x4*)pr)[lane]; v2u w; w.x = pk2(v[0], v[1]); w.y = pk2(v[2], v[3]); ((v2u*)(PBF + (size_t)m * PLE))[lane] = w;
        }
        for (int idx = bx * (NWAVES * 64) + tid; idx < ROPE_ROWS * 16; idx += G * NWAVES * 64) {
            const int pr = idx >> 4, i = idx & 15; const int pos = pr < SEQ ? pr : PAST + (pr - SEQ);
            const float freq = powf(500000.0f, -(float)i * (1.0f / 16.0f));
            const float ang = (float)pos * freq;
            const double rev = (double)ang * 0.15915494309189535;
            const float fr = (float)(rev - rint(rev));
            ROPE[(size_t)pr * 32 + i] = __builtin_amdgcn_cosf(fr); ROPE[(size_t)pr * 32 + 16 + i] = __builtin_amdgcn_sinf(fr);
        }
    }
    SEAM(0);

    if (PH1 && IN(1)) { PHASE_BASES();
        {
            pg8::Gemm g{Hb, W1T, MP, N1, DM}; pg8::StaticOrder S; S.init(MP, N1, G, bx);
            EpiP1 E{Qb, Kb, Vb, Ub, VGb, GAb, GBb, OUTP + OK_P, OUTP + OV_P, ROPE, KMP, RSUM, RSQ};
            pg8::gemm_phase<EpiP1, pg8::StaticOrder, true, true>(lds + RING_OFF, g, S, E);
        }
        {
            pg8::Gemm g{PBF, WPLT, MP, DM, PLE}; pg8::StaticOrder S; S.init(MP, DM, G, bx);
            EpiBf E{PWb, DM};
            pg8::gemm_phase<EpiBf, pg8::StaticOrder, true, true>(lds + RING_OFF, g, S, E);
        }
        {
            SEpiP1 E{Qb, Kb, Vb, Ub, VGb, GAb, GBb, OUTP + OK_S, OUTP + OV_S, ROPE, RSUM, RSQ};
            sample_gemm<4, SEpiP1>(lds, Hb + (size_t)MP * DM, W1T, N1, DM, G - 1 - bx, G, E);
            SEpiBf E2{PWb, DM};
            sample_gemm<2, SEpiBf>(lds, PBF + (size_t)MP * PLE, WPLT, DM, PLE, bx, G, E2);
        }
    }
    SEAM(1);

    if (PH2 && IN(2)) { PHASE_BASES();
        const int nA = 128;
        if (bx < nA) {
            att::Seam S;
            { const int a = bx;
                const int bh = a >> 2, x = a & 3, b = bh >> 3, h = bh & 7;
                const att::bf16* Kp = Kb + (size_t)b * SEQ * 1024 + h * 128; const att::bf16* Vp = Vb + (size_t)b * SEQ * 1024 + h * 128;
                const float* km = KMP + (size_t)(b * 8) * 2048 + h * 128;
                att::BlockRef c0{Qb + ((size_t)b * SEQ + x * 256) * 1024 + h * 128, Kp, Vp, ATTb + ((size_t)b * SEQ + x * 256) * 1024 + h * 128, km, x * 256};
                att::BlockRef c1{Qb + ((size_t)b * SEQ + (7 - x) * 256) * 1024 + h * 128, Kp, Vp, ATTb + ((size_t)b * SEQ + (7 - x) * 256) * 1024 + h * 128, km, (7 - x) * 256};
                att::moba_gate(c0, (char*)lds_raw); att::moba_gate(c1, (char*)lds_raw);
                att::moba_prime(c0, (char*)lds_raw, S);
                att::moba_block(c0, c1, (char*)lds_raw, S);
                att::moba_block(c1, c1, (char*)lds_raw, S);
            }
        } else {
            const int o = bx - nA, nO = G - nA;
            for (int u = o; u < 64 * 8; u += nO) gmlp_unit(lds, u, Ub, VGb, RSUM, RSQ, g_vn, w_sp, b_sp, GMb);
            for (int u = o; u < DECB * NH * DECS; u += nO) sattn_unit(lds, u, Qb, KMS, cache_k, cache_v, ptab, OUTP + OK_S, OUTP + OV_S, ATTb);
            if (o == nO - 1) sgmlp_all(Ub, VGb, RSUM, RSQ, g_vn, w_sp, b_sp, GMb, OUTP + OGV_S);
        }
    }
    SEAM(2);

    if (PH3 && IN(3)) { PHASE_BASES();
        pg8::Gemm g{ATTb, WAT, MP, DM, AW}; pg8::StaticOrder S; S.init(MP, DM, G, bx);
        EpiT E{Tf, GAb};
        pg8::gemm_phase<EpiT, pg8::StaticOrder, true, true>(lds + RING_OFF, g, S, E);
        SEpiT E2{Tf, GAb};
        sample_gemm<4, SEpiT>(lds, ATTb + (size_t)MP * AW, WAT, DM, AW, bx, G, E2);
    }
    SEAM(3);
    if (PH4 && IN(4)) { PHASE_BASES();
        pg8::Gemm g{GMb, WBT, MP, DM, GW}; pg8::StaticOrder S; S.init(MP, DM, G, bx);
        EpiMix E{Tf, GBb, MIXINb};
        pg8::gemm_phase<EpiMix, pg8::StaticOrder, true, true>(lds + RING_OFF, g, S, E);
        SEpiMix E2{Tf, GBb, MIXINb};
        sample_gemm<4, SEpiMix>(lds, GMb + (size_t)MP * GW, WBT, DM, GW, bx, G, E2);
    }
    SEAM(4);
    if (PH5 && IN(5)) { PHASE_BASES();
        pg8::Gemm g{MIXINb, WOT, MP, DM, DM}; pg8::StaticOrder S; S.init(MP, DM, G, bx);
        EpiF32 E{MIXF, DM};
        pg8::gemm_phase<EpiF32, pg8::StaticOrder, true, true>(lds + RING_OFF, g, S, E);
        SEpiF32 E2{MIXF, DM};
        sample_gemm<4, SEpiF32>(lds, MIXINb + (size_t)MP * DM, WOT, DM, DM, bx, G, E2);
    }
    SEAM(5);
    if (PH6 && IN(6)) { PHASE_BASES();
        for (int m = gw; m < MT; m += NGW) {
            const float* xr = m < MP ? x_p + (size_t)m * DM : x_s + (size_t)(m - MP) * DM;
            norm_residual_row(MIXF + (size_t)m * DM, xr, g_post_mix, X1 + (size_t)m * DM, g_pre_ffn, XN1 + (size_t)m * DM, lane);
        }
    }
    SEAM(6);
    if (PH7 && IN(7)) { PHASE_BASES();
        pg8::Gemm g{XN1, WF1T, MP, NF1, DM}; pg8::StaticOrder S; S.init(MP, NF1, G, bx);
        EpiSwiglu E{HIDb};
        pg8::gemm_phase<EpiSwiglu, pg8::StaticOrder, true, true>(lds + RING_OFF, g, S, E);
        SEpiSwiglu E2{HIDb};
        sample_gemm_swiglu<SEpiSwiglu>(lds, XN1 + (size_t)MP * DM, WF1T, DM, G - 1 - bx, G, E2);
    }
    SEAM(7);
    if (PH8 && IN(8)) { PHASE_BASES();
        pg8::Gemm g{HIDb, WF2T, MP, DM, FF}; pg8::StaticOrder S; S.init(MP, DM, G, bx);
        EpiF32 E{MIXF, DM};
        pg8::gemm_phase<EpiF32, pg8::StaticOrder, true, true>(lds + RING_OFF, g, S, E);
        SEpiF32 E2{MIXF, DM};
        sample_gemm<4, SEpiF32>(lds, HIDb + (size_t)MP * FF, WF2T, DM, FF, bx, G, E2);
    }
    SEAM(8);
    if (PH9 && IN(9)) { PHASE_BASES();
        for (int m = gw; m < MT; m += NGW)
            norm_residual_row(MIXF + (size_t)m * DM, X1 + (size_t)m * DM, g_post_ffn, X2 + (size_t)m * DM, g_ple, XN2 + (size_t)m * DM, lane);
    }
    SEAM(9);
    if (PH10 && IN(10)) { PHASE_BASES();
        pg8::Gemm g{XN2, WPGT, MP, DM, DM}; pg8::StaticOrder S; S.init(MP, DM, G, bx);
        EpiY E{X2, PWb, OUTP + OY_P};
        pg8::gemm_phase<EpiY, pg8::StaticOrder, true, true>(lds + RING_OFF, g, S, E);
        SEpiY E2{X2, PWb, OUTP + OY_S};
        sample_gemm<4, SEpiY>(lds, XN2 + (size_t)MP * DM, WPGT, DM, DM, bx, G, E2);
    }
#undef IN
#undef SEAM
}

#ifndef MK_SPLIT
#define MK_SPLIT 0
#endif
extern "C" void kernel_launch(void* const* d_in, const int* in_sizes, int n_in, void* d_out, int out_size, void* d_ws, size_t ws_size, hipStream_t stream) {
    static int grid = 0;
    if (grid == 0) {
        if (n_in != 24 || out_size != (int)OUT_TOTAL || ws_size < WS_END) { fprintf(stderr, "kernel_launch: unexpected shapes (n_in %d, out %d, ws %zu)\n", n_in, out_size, ws_size); grid = -1; return; }
        int dev = 0, cus = 0, per_cu = 0;
        if (hipGetDevice(&dev) != hipSuccess || hipDeviceGetAttribute(&cus, hipDeviceAttributeMultiprocessorCount, dev) != hipSuccess) { grid = -1; return; }
        if (hipFuncSetAttribute((const void*)moba_fwd, hipFuncAttributeMaxDynamicSharedMemorySize, LDS_BYTES) != hipSuccess) { fprintf(stderr, "kernel_launch: hipFuncSetAttribute failed\n"); grid = -1; return; }
        if (hipOccupancyMaxActiveBlocksPerMultiprocessor(&per_cu, (const void*)moba_fwd, NWAVES * 64, LDS_BYTES) != hipSuccess || per_cu < 1) fprintf(stderr, "kernel_launch: occupancy query says %d\n", per_cu);
        (void)hipGetLastError();
        if (cus < 256) { fprintf(stderr, "kernel_launch: built for a 256-CU device (got %d)\n", cus); grid = -1; return; }
        grid = 256;
    }
    if (grid < 0) return;
    if (hipMemsetAsync((char*)d_ws + WS_CTL, 0, CTL_ZERO_BYTES, stream) != hipSuccess) return;
    Args a{};
    for (int i = 0; i < 24; ++i) a.in[i] = d_in[i];
    a.out = (float*)d_out; a.ws = (unsigned char*)d_ws;
#if MK_SPLIT
    for (int p = 0; p < N_PHASES; ++p) { a.ph_lo = p; a.ph_hi = p + 1; hipLaunchKernelGGL(moba_fwd, dim3(grid), dim3(NWAVES * 64), LDS_BYTES, stream, a); }
#else
    a.ph_lo = 0; a.ph_hi = N_PHASES;
    hipLaunchKernelGGL(moba_fwd, dim3(grid), dim3(NWAVES * 64), LDS_BYTES, stream, a);
#endif
}
```
